# Optimizing an MI355X kernel written in HIP

```python
import math
import jax
import jax.numpy as jnp
from jax import lax
import numpy as np

D_MODEL = 1024
BATCH = 2
SEQ = 8192
DEPTH = 4

GRID_W = 64
CTX_LEN = 256
N_EVEN = (DEPTH + 1) // 2
N_ODD = DEPTH // 2
MIX_W = D_MODEL // 2
GMLP_CHUNK = 128
A_GROUPS = 4
A_GROUP_DIM = MIX_W // A_GROUPS
B_HEADS = 4
B_HEAD_DIM = MIX_W // B_HEADS
B_HALF = B_HEAD_DIM // 2
DIFF_SCALE = B_HALF ** -0.5
Q_BLOCK = 128
C_HEADS = 4
C_DIM = MIX_W // C_HEADS
C_SCALE = C_DIM ** -0.5
D_HEADS = 4
D_DIM = MIX_W // D_HEADS
D_SCALE = D_DIM ** -0.5
SCAN_CHUNK = 64
PEER_HEADS = 8
N_KEYS = 128
N_EXPERTS = N_KEYS * N_KEYS
PK_DIM = 128
PK_TOPK = 16
PEER_TOPK = 16
PEER_BLOCK = 128
ROPE_BASE = 10000.0
EPS = 1e-6

kernel_name = 'hybrid_gmlp_diffattn_hgrn2_retnet_peer_dit'


def rms_norm(x, g):
    xf = x.astype(jnp.float32)
    y = xf * lax.rsqrt(jnp.mean(xf * xf, axis=-1, keepdims=True) + EPS)
    return (y * g.astype(jnp.float32)).astype(x.dtype)


def layer_norm(x, g):
    xf = x.astype(jnp.float32)
    xc = xf - jnp.mean(xf, axis=-1, keepdims=True)
    y = xc * lax.rsqrt(jnp.mean(xc * xc, axis=-1, keepdims=True) + EPS)
    return (y * g.astype(jnp.float32)).astype(x.dtype)


def modulate(h, shift, scale):
    return h * (1.0 + scale) + shift


def to_heads(a, n_heads):
    b, t, _ = a.shape
    return a.reshape(b, t, n_heads, -1).transpose(0, 2, 1, 3)


def from_heads(a):
    b, h, t, d = a.shape
    return a.transpose(0, 2, 1, 3).reshape(b, t, h * d)


def rope_1d(x, pos):
    half = x.shape[-1] // 2
    inv = ROPE_BASE ** (-jnp.arange(half, dtype=jnp.float32) / half)
    ang = pos.astype(jnp.float32)[:, None] * inv[None, :]
    cos, sin = jnp.cos(ang), jnp.sin(ang)
    xf = x.astype(jnp.float32)
    x1, x2 = xf[..., :half], xf[..., half:]
    return jnp.concatenate([x1 * cos - x2 * sin, x1 * sin + x2 * cos], axis=-1).astype(x.dtype)


def rope_2d(x, rows, cols):
    h = x.shape[-1] // 2
    return jnp.concatenate([rope_1d(x[..., :h], rows), rope_1d(x[..., h:], cols)], axis=-1)


def chunk_gmlp(uv, ws, bs, v_gain):
    u, v = jnp.split(jax.nn.gelu(uv), 2, axis=-1)
    v = layer_norm(v, v_gain)
    b, t, _ = v.shape
    vc = v.reshape(b, t // GMLP_CHUNK, GMLP_CHUNK, A_GROUPS, A_GROUP_DIM)
    z = jnp.einsum('gpq,bnqgd->bnpgd', ws, vc) + bs.T[:, :, None]
    return u * z.reshape(b, t, MIX_W)


def diff_attend(q1, q2, k1, k2, v, lam):
    s1 = jnp.einsum('bhqd,bhkd->bhqk', q1, k1).astype(jnp.float32) * DIFF_SCALE
    s2 = jnp.einsum('bhqd,bhkd->bhqk', q2, k2).astype(jnp.float32) * DIFF_SCALE
    p = jax.nn.softmax(s1, axis=-1) - lam * jax.nn.softmax(s2, axis=-1)
    return jnp.einsum('bhqk,bhkd->bhqd', p.astype(v.dtype), v)


def mixer_ab(hx, hy, w_in, ws, bs, v_gain, lam_vecs, sub_gain, lam_init, rows, cols, with_ctx):
    w_kv, w_rest = w_in[:, :2 * MIX_W], w_in[:, 2 * MIX_W:]

    def keys_values(h):
        k, v = jnp.split(h @ w_kv, 2, axis=-1)
        k1, k2 = jnp.split(to_heads(k, B_HEADS), 2, axis=-1)
        return k1, k2, to_heads(v, B_HEADS)

    def gmlp_and_queries(h):
        uv, q = jnp.split(h @ w_rest, [2 * MIX_W], axis=-1)
        q1, q2 = jnp.split(to_heads(q, B_HEADS), 2, axis=-1)
        return uv, q1, q2

    lv = lam_vecs.astype(jnp.float32)
    lam = jnp.exp(jnp.dot(lv[0], lv[1])) - jnp.exp(jnp.dot(lv[2], lv[3])) + lam_init

    def finish(uv, o):
        o = from_heads(rms_norm(o, sub_gain) * (1.0 - lam_init))
        return jnp.concatenate([chunk_gmlp(uv, ws, bs, v_gain), o], axis=-1)

    k1y, k2y, vy = keys_values(hy)
    k1x, k2x, vx = keys_values(hx)
    uvx, q1x, q2x = gmlp_and_queries(hx)
    q1x, q2x, k1x, k2x = (rope_2d(a, rows, cols) for a in (q1x, q2x, k1x, k2x))
    k1a = jnp.concatenate([k1x, k1y], axis=2)
    k2a = jnp.concatenate([k2x, k2y], axis=2)
    va = jnp.concatenate([vx, vy], axis=2)
    b, h, n, _ = q1x.shape
    nb = n // Q_BLOCK

    def blocks(a):
        return jnp.moveaxis(a.reshape(b, h, nb, Q_BLOCK, B_HALF), 2, 0)

    ob = lax.map(lambda qs: diff_attend(qs[0], qs[1], k1a, k2a, va, lam), (blocks(q1x), blocks(q2x)))
    ox = finish(uvx, jnp.moveaxis(ob, 0, 2).reshape(b, h, n, B_HEAD_DIM))
    if not with_ctx:
        return ox, None
    uvy, q1y, q2y = gmlp_and_queries(hy)
    oy = finish(uvy, diff_attend(q1y, q2y, k1y, k2y, vy, lam))
    return ox, oy


def gated_chunk_scan(k, v, log_f, s0, q=None):
    b, h, t, kd = k.shape
    n = t // SCAN_CHUNK

    def chunks(a):
        return jnp.moveaxis(a.reshape(b, h, n, SCAN_CHUNK, a.shape[-1]), 2, 0)

    lower = jnp.tril(jnp.ones((SCAN_CHUNK, SCAN_CHUNK), bool))[:, :, None]
    xs = (chunks(k), chunks(v), chunks(log_f)) + (() if q is None else (chunks(q),))

    def step(s, blk):
        kb = blk[0].astype(jnp.float32)
        vb = blk[1].astype(jnp.float32)
        cum = jnp.cumsum(blk[2].astype(jnp.float32), axis=2)
        end = cum[:, :, -1]
        s_new = jnp.exp(end)[..., None] * s + jnp.einsum('bhck,bhcv->bhkv', kb * jnp.exp(end[:, :, None] - cum), vb)
        if q is None:
            return s_new, None
        qb = blk[3].astype(jnp.float32)
        o = jnp.einsum('bhck,bhkv->bhcv', qb * jnp.exp(cum), s)
        rel = jnp.where(lower, jnp.exp(jnp.minimum(cum[:, :, :, None] - cum[:, :, None], 0.0)), 0.0)
        att = jnp.einsum('bhtk,bhsk,bhtsk->bhts', qb, kb, rel)
        return s_new, o + jnp.einsum('bhts,bhsv->bhtv', att, vb)

    s_end, o = lax.scan(step, s0, xs)
    if q is None:
        return None, s_end
    return jnp.moveaxis(o, 0, 2).reshape(b, h, t, v.shape[-1]).astype(v.dtype), s_end


def bidir_scan(dirs, v, s0_fwd, s0_bwd, q):
    (k_f, lf_f), (k_b, lf_b) = dirs

    def flip(a):
        return jnp.flip(a, axis=2)

    o_f, s_f = gated_chunk_scan(k_f, v, lf_f, s0_fwd, q)
    o_b, s_b = gated_chunk_scan(flip(k_b), flip(v), flip(lf_b), s0_bwd, None if q is None else flip(q))
    o = None if q is None else o_f + flip(o_b)
    return o, s_f, s_b


def mixer_cd(hx, hy, w_in, lb, hg_gain, ret_decay, ret_gain, rows, cols, with_ctx):
    w_state, w_query = w_in[:, :5 * MIX_W], w_in[:, 5 * MIX_W:]
    log_gamma = -jnp.exp(ret_decay.astype(jnp.float32))
    lb_h = lb.reshape(C_HEADS, 1, C_DIM)

    def scan_inputs(h, rotate):
        f_fw, f_bw, i_in, rk, rv = (to_heads(a, C_HEADS) for a in jnp.split(h @ w_state, 5, axis=-1))
        if rotate:
            rk = rope_2d(rk, rows, cols)
        rk = (rk * D_SCALE).astype(jnp.float32)
        b, _, t, _ = rk.shape
        dirs = []
        for d, f_logit in enumerate((f_fw, f_bw)):
            f = lb_h + (1.0 - lb_h) * jax.nn.sigmoid(f_logit.astype(jnp.float32))
            lf_ret = jnp.broadcast_to(log_gamma[d][None, :, None, None], (b, D_HEADS, t, D_DIM))
            dirs.append((jnp.concatenate([1.0 - f, rk], axis=1), jnp.concatenate([jnp.log(f), lf_ret], axis=1)))
        return dirs, jnp.concatenate([i_in, rv], axis=1)

    def queries(h, rotate):
        hq, hg, rq, rg = jnp.split(h @ w_query, 4, axis=-1)
        hq = to_heads(jax.nn.silu(hq), C_HEADS) * C_SCALE
        rq = to_heads(rq, D_HEADS)
        if rotate:
            rq = rope_2d(rq, rows, cols)
        return jnp.concatenate([hq, rq], axis=1), hg, rg

    def outputs(o, hg, rg):
        oh = rms_norm(o[:, :C_HEADS] * jax.nn.sigmoid(to_heads(hg, C_HEADS)), hg_gain)
        orr = from_heads(layer_norm(o[:, C_HEADS:], ret_gain)) * jax.nn.silu(rg)
        return jnp.concatenate([from_heads(oh), orr], axis=-1)

    b = hx.shape[0]
    zeros = jnp.zeros((b, C_HEADS + D_HEADS, C_DIM, D_DIM), jnp.float32)
    dirs_y, v_y = scan_inputs(hy, False)
    q_y, hg_y, rg_y = queries(hy, False) if with_ctx else (None, None, None)
    o_y, s_yf, s_yb = bidir_scan(dirs_y, v_y, zeros, zeros, q_y)
    dirs_x, v_x = scan_inputs(hx, True)
    q_x, hg_x, rg_x = queries(hx, True)
    o_x, _, _ = bidir_scan(dirs_x, v_x, s_yf, s_yb, q_x)
    ox = outputs(o_x, hg_x, rg_x)
    oy = outputs(o_y, hg_y, rg_y) if with_ctx else None
    return ox, oy


def peer(h, wq, sub_keys, u_tab, v_tab):
    b, t, d = h.shape
    z = h.reshape(-1, PEER_BLOCK, d)

    def block(zb):
        q = (zb @ wq).reshape(PEER_BLOCK, PEER_HEADS, 2, PK_DIM)
        s = jnp.einsum('nhpd,hpkd->nhpk', q, sub_keys).astype(jnp.float32)
        sv, si = lax.top_k(s, PK_TOPK)
        cand = (sv[:, :, 0, :, None] + sv[:, :, 1, None, :]).reshape(PEER_BLOCK, PEER_HEADS, PK_TOPK * PK_TOPK)
        cid = (si[:, :, 0, :, None] * N_KEYS + si[:, :, 1, None, :]).reshape(PEER_BLOCK, PEER_HEADS, PK_TOPK * PK_TOPK)
        best, pos = lax.top_k(cand, PEER_TOPK)
        eid = jnp.take_along_axis(cid, pos, axis=-1)
        gate = jax.nn.softmax(best, axis=-1)
        act = jax.nn.gelu(jnp.einsum('nd,nhkd->nhk', zb, u_tab[eid]).astype(jnp.float32))
        return jnp.einsum('nhk,nhkd->nd', (gate * act).astype(zb.dtype), v_tab[eid])

    return lax.map(block, z).reshape(b, t, d)


def setup_inputs(seed: int = 0) -> dict:
    key = jax.random.key(seed)
    ks = jax.random.split(key, 32)
    d = D_MODEL

    def nrm(k, shape, s):
        return jax.random.normal(k, shape, jnp.float32) * s

    base_decay = jnp.log(-jnp.log1p(-(2.0 ** (-5.0 - jnp.arange(D_HEADS, dtype=jnp.float32)))))
    return {
        'x': nrm(ks[0], (BATCH, SEQ, d), 1.0),
        'c': nrm(ks[1], (BATCH, d), 1.0),
        'ctx': nrm(ks[2], (BATCH, CTX_LEN, d), 1.0),
        'c_ctx': nrm(ks[3], (d,), 1.0),
        'w_ada': nrm(ks[4], (DEPTH, d, 6 * d), 0.5 * d ** -0.5),
        'b_ada': nrm(ks[5], (DEPTH, 6 * d), 0.02),
        'norm_g': 1.0 + nrm(ks[6], (DEPTH, 2, d), 0.02),
        'w_in_even': nrm(ks[7], (N_EVEN, d, 5 * MIX_W), d ** -0.5),
        'gmlp_ws': nrm(ks[8], (N_EVEN, A_GROUPS, GMLP_CHUNK, GMLP_CHUNK), GMLP_CHUNK ** -0.5),
        'gmlp_bs': 1.0 + nrm(ks[9], (N_EVEN, A_GROUPS, GMLP_CHUNK), 0.02),
        'gmlp_v_gain': 1.0 + nrm(ks[10], (N_EVEN, MIX_W), 0.02),
        'diff_lambda': nrm(ks[11], (N_EVEN, 4, B_HALF), 0.1),
        'diff_sub_gain': 1.0 + nrm(ks[12], (N_EVEN, B_HEAD_DIM), 0.02),
        'w_in_odd': nrm(ks[13], (N_ODD, d, 9 * MIX_W), d ** -0.5),
        'hgrn_lower_bounds': nrm(ks[14], (DEPTH, MIX_W), 0.5),
        'hgrn_gain': 1.0 + nrm(ks[15], (N_ODD, C_DIM), 0.02),
        'ret_log_decay': base_decay[None, None, :] + nrm(ks[16], (N_ODD, 2, D_HEADS), 0.1),
        'ret_gain': 1.0 + nrm(ks[17], (N_ODD, D_DIM), 0.02),
        'w_out': nrm(ks[18], (DEPTH, 2 * MIX_W, d), (2 * MIX_W) ** -0.5),
        'peer_wq': nrm(ks[19], (DEPTH, d, PEER_HEADS * 2 * PK_DIM), d ** -0.5),
        'peer_sub_keys': nrm(ks[20], (DEPTH, PEER_HEADS, 2, N_KEYS, PK_DIM), PK_DIM ** -0.5),
        'peer_u': nrm(ks[21], (DEPTH, N_EXPERTS, d), d ** -0.5),
        'peer_v': nrm(ks[22], (DEPTH, N_EXPERTS, d), 0.5),
        'final_g': 1.0 + nrm(ks[23], (d,), 0.02),
    }


def reference(x, c, ctx, c_ctx, w_ada, b_ada, norm_g, w_in_even, gmlp_ws, gmlp_bs,
              gmlp_v_gain, diff_lambda, diff_sub_gain, w_in_odd, hgrn_lower_bounds,
              hgrn_gain, ret_log_decay, ret_gain, w_out, peer_wq, peer_sub_keys,
              peer_u, peer_v, final_g):
    n_tok = x.shape[1]
    n_rows = n_tok // GRID_W
    rows = jnp.repeat(jnp.arange(n_rows), GRID_W)
    cols = jnp.tile(jnp.arange(GRID_W), n_rows)
    lb_all = jnp.cumsum(jax.nn.softmax(hgrn_lower_bounds.astype(jnp.float32), axis=0), axis=0)
    lb_all = lb_all - lb_all[0]
    y = ctx
    n_ctx = ctx.shape[1]
    for i in range(DEPTH):
        last = i == DEPTH - 1
        j = i // 2
        mod_x = jax.nn.silu(c) @ w_ada[i] + b_ada[i]
        mod_y = jax.nn.silu(c_ctx) @ w_ada[i] + b_ada[i]
        sh1, sc1, g1, sh2, sc2, g2 = jnp.split(mod_x[:, None, :], 6, axis=-1)
        csh1, csc1, cg1, csh2, csc2, cg2 = jnp.split(mod_y, 6, axis=-1)
        hx = modulate(rms_norm(x, norm_g[i, 0]), sh1, sc1)
        hy = modulate(rms_norm(y, norm_g[i, 0]), csh1, csc1)
        if i % 2 == 0:
            lam_init = 0.8 - 0.6 * math.exp(-0.3 * i)
            ox, oy = mixer_ab(hx, hy, w_in_even[j], gmlp_ws[j], gmlp_bs[j], gmlp_v_gain[j],
                              diff_lambda[j], diff_sub_gain[j], lam_init, rows, cols, not last)
        else:
            ox, oy = mixer_cd(hx, hy, w_in_odd[j], lb_all[i], hgrn_gain[j], ret_log_decay[j],
                              ret_gain[j], rows, cols, not last)
        x = x + g1 * (ox @ w_out[i])
        hx2 = modulate(rms_norm(x, norm_g[i, 1]), sh2, sc2)
        if last:
            x = x + g2 * peer(hx2, peer_wq[i], peer_sub_keys[i], peer_u[i], peer_v[i])
        else:
            y = y + cg1 * (oy @ w_out[i])
            hy2 = modulate(rms_norm(y, norm_g[i, 1]), csh2, csc2)
            p = peer(jnp.concatenate([hy2, hx2], axis=1), peer_wq[i], peer_sub_keys[i], peer_u[i], peer_v[i])
            y = y + cg2 * p[:, :n_ctx]
            x = x + g2 * p[:, n_ctx:]
    return rms_norm(x, final_g)
```

```cpp
#include <hip/hip_runtime.h>
#include <cstdio>
#include <cstdint>

#ifndef MK_SINGLE
#define MK_SINGLE 1
#endif

#define DEVI __device__ __forceinline__
#define LAS __attribute__((address_space(3)))

typedef unsigned short bf16;
typedef float f32x4 __attribute__((ext_vector_type(4)));
typedef unsigned u32x4 __attribute__((ext_vector_type(4)));
typedef unsigned u32x2 __attribute__((ext_vector_type(2)));
typedef float f32x2 __attribute__((ext_vector_type(2)));

constexpr int D = 1024, SEQ = 8192, NCTX = 256, DEPTH = 4;
constexpr int TX = 2 * SEQ, TC = 2 * NCTX, T = TX + TC;
constexpr int NSEQ = SEQ + NCTX;
constexpr int NCHUNK = NSEQ / 64;
constexpr float EPS = 1e-6f;
constexpr float LOG2E = 1.4426950408889634f;
constexpr float DIFF_SCALE = 0.125f, HEAD_SCALE = 0.08838834764831845f;
constexpr int NPH_LAYER = 13, NPHASES = 1 + DEPTH * NPH_LAYER + 1;
constexpr int NTHR = 512, NWV = NTHR / 64;

constexpr size_t MiB = 1u << 20;
constexpr size_t WS_CTL = 0;
constexpr size_t WS_MOD = 1 * MiB;
constexpr size_t WS_LB = WS_MOD + 512 * 1024, WS_LAM = WS_MOD + 768 * 1024;
constexpr size_t WS_SHQ = WS_MOD + 800 * 1024;
constexpr size_t WS_RSS = 58 * MiB;
constexpr size_t WS_WT = 2 * MiB;
constexpr size_t WS_XA = 66 * MiB;
constexpr size_t WS_H = 132 * MiB;
constexpr size_t WS_OX = 165 * MiB;
constexpr size_t WS_ACT = 198 * MiB;
constexpr size_t TB512 = (size_t)T * 512 * 2;
constexpr size_t WS_KB = WS_ACT, WS_VB = WS_ACT + TB512, WS_QB = WS_ACT + 2 * TB512, WS_UB = WS_ACT + 3 * TB512, WS_VG = WS_ACT + 4 * TB512;
constexpr size_t WS_LF = WS_ACT;
constexpr size_t WS_VS = WS_ACT + 66 * MiB;
constexpr size_t WS_KR = WS_VS + 33 * MiB;
constexpr size_t WS_QS = WS_KR + TB512;
constexpr size_t WS_G = WS_QS + 33 * MiB;
constexpr size_t WS_OFB = 390 * MiB;
constexpr size_t WS_UT = 522 * MiB;
constexpr size_t WS_DEC = 786 * MiB;
constexpr size_t WS_QP = 522 * MiB;
constexpr size_t WS_SC = 588 * MiB;
constexpr size_t WS_EID = 720 * MiB;
constexpr size_t WS_GATE = 729 * MiB;
constexpr size_t WS_TAB = 792 * MiB;
constexpr size_t WS_END = 856 * MiB;

struct Params {
    const float *x, *c, *ctx, *c_ctx, *w_ada, *b_ada, *norm_g, *w_in_even, *gmlp_ws, *gmlp_bs, *gmlp_v_gain, *diff_lambda, *diff_sub_gain,
        *w_in_odd, *hgrn_lb, *hgrn_gain, *ret_log_decay, *ret_gain, *w_out, *peer_wq, *peer_sub_keys, *peer_u, *peer_v, *final_g;
    float* out; unsigned char* ws; int ph_lo, ph_hi;
};

DEVI float bf2f(bf16 h) { return __uint_as_float((unsigned)h << 16); }
DEVI unsigned f2bf(float f) { unsigned u = __float_as_uint(f); return (u + 0x7fffu + ((u >> 16) & 1u)) >> 16; }
typedef __bf16 bf16x2n __attribute__((ext_vector_type(2)));
DEVI unsigned pk2(float lo, float hi) { const bf16x2n v = {(__bf16)lo, (__bf16)hi}; return __builtin_bit_cast(unsigned, v); }
DEVI u32x2 pk4(const f32x4 v) { u32x2 o; o.x = pk2(v.x, v.y); o.y = pk2(v.z, v.w); return o; }
DEVI float bflo(unsigned w) { return __uint_as_float(w << 16); }
DEVI float bfhi(unsigned w) { return __uint_as_float(w & 0xffff0000u); }
DEVI float wave_sum(float v) {
#pragma unroll
    for (int o = 32; o >= 1; o >>= 1) v += __shfl_xor(v, o);
    return v;
}
DEVI float wave_max(float v) {
#pragma unroll
    for (int o = 32; o >= 1; o >>= 1) v = fmaxf(v, __shfl_xor(v, o));
    return v;
}
DEVI float half_sum(float v) {
#pragma unroll
    for (int o = 16; o >= 1; o >>= 1) v += __shfl_xor(v, o);
    return v;
}
DEVI float sigmoid_(float x) { return 1.f / (1.f + __expf(-x)); }
DEVI float silu_(float x) { return x * sigmoid_(x); }
DEVI float gelu_(float x) { const float u = 1.5957691216057308f * (x + 0.044715f * x * x * x); return x / (1.f + __expf(-u)); }
DEVI int mod_index(int r) { return r < TX ? (r >> 13) : 2; }
DEVI float rss_rstd(const float* rssp) { const f32x4 a = *(const f32x4*)rssp, b = *(const f32x4*)(rssp + 4), c = *(const f32x4*)(rssp + 8), d = *(const f32x4*)(rssp + 12);
    const float s = ((a.x + a.y) + (a.z + a.w)) + ((b.x + b.y) + (b.z + b.w)) + (((c.x + c.y) + (c.z + c.w)) + ((d.x + d.y) + (d.z + d.w))); return rsqrtf(s * (1.f / 1024.f) + EPS); }
DEVI int scan_row(int b, int dir, int j) {
    if (j < NCTX) return TX + b * NCTX + (dir ? NCTX - 1 - j : j);
    const int t = j - NCTX; return b * SEQ + (dir ? SEQ - 1 - t : t);
}

#define XB_TMO 128
#define XB_XCNT(j) (256 + 64 * (j))
#define XB_XSUB(j) (1280 + 64 * (j))
#define XB_XGEN(j) (2304 + 64 * (j))
#define XB_TOP 3328
#define XB_TOPGEN 3392
#define XB_SPIN_CAP (1u << 22)
DEVI unsigned xb_ld(unsigned* p) { return __hip_atomic_load(p, __ATOMIC_RELAXED, __HIP_MEMORY_SCOPE_AGENT); }
DEVI unsigned xb_add(unsigned* p, unsigned v) { return __hip_atomic_fetch_add(p, v, __ATOMIC_RELAXED, __HIP_MEMORY_SCOPE_AGENT); }
DEVI unsigned xb_xcc_id() { return (unsigned)__builtin_amdgcn_s_getreg((3 << 11) | 20) & 0xFu; }
#define XB_SPIN(cond, bar) do { unsigned _sp = 0; while (cond) { __builtin_amdgcn_s_sleep(1); \
    if ((++_sp & 255u) == 0u) { if (xb_ld(&(bar)[XB_TMO])) break; if (_sp > XB_SPIN_CAP) { atomicAdd(&(bar)[XB_TMO], 1u); break; } } } } while (0)
struct XcdBarrier { unsigned* bar; unsigned x; volatile unsigned* st; };
DEVI XcdBarrier xcd_barrier_post(unsigned* bar, volatile unsigned* st) {
    XcdBarrier b; b.bar = bar; b.x = xb_xcc_id(); b.st = st;
    if (threadIdx.x == 0) (void)xb_add(&bar[XB_XCNT(b.x)], 1u);
    return b;
}
DEVI void xcd_barrier_complete(unsigned* bar, unsigned x, unsigned& nloc, unsigned& nx) {
    const unsigned G = gridDim.x; unsigned sum, cnt, mine, sp = 0u;
    for (;;) {
        sum = 0u; cnt = 0u; mine = 0u;
#pragma unroll
        for (unsigned j = 0; j < 16; ++j) { const unsigned c = xb_ld(&bar[XB_XCNT(j)]); sum += c; cnt += (c > 0u) ? 1u : 0u; mine = (j == x) ? c : mine; }
        if (sum == G) break;
        __builtin_amdgcn_s_sleep(1);
        if ((++sp & 255u) == 0u) { if (xb_ld(&bar[XB_TMO])) break; if (sp > XB_SPIN_CAP) { atomicAdd(&bar[XB_TMO], 1u); break; } }
    }
    nloc = mine > 0u ? mine : 1u; nx = cnt > 0u ? cnt : 1u;
}
DEVI void xcd_barrier(const XcdBarrier& b) {
    asm volatile("s_waitcnt vmcnt(0)" ::: "memory");
    __syncthreads();
    if (threadIdx.x == 0) {
        unsigned* bar = b.bar;
        __builtin_amdgcn_s_waitcnt(0);
        unsigned nloc = b.st[0], nx = b.st[1];
        if (nloc == 0u) { xcd_barrier_complete(bar, b.x, nloc, nx); b.st[0] = nloc; b.st[1] = nx; }
        const unsigned old = xb_add(&bar[XB_XSUB(b.x)], 1u);
        const unsigned gen = old / nloc;
        if (old + 1u == (gen + 1u) * nloc) {
            __builtin_amdgcn_fence(__ATOMIC_RELEASE, "agent");
            asm volatile("s_waitcnt vmcnt(0)" ::: "memory");
            const unsigned og = xb_add(&bar[XB_TOP], 1u);
            const unsigned tg = og / nx;
            if (og + 1u == (tg + 1u) * nx) xb_add(&bar[XB_TOPGEN], 1u);
            else XB_SPIN(xb_ld(&bar[XB_TOPGEN]) == tg, bar);
            __builtin_amdgcn_fence(__ATOMIC_ACQUIRE, "agent");
            xb_add(&bar[XB_XGEN(b.x)], 1u);
            asm volatile("s_waitcnt vmcnt(0)" ::: "memory");
        } else {
            XB_SPIN(xb_ld(&bar[XB_XGEN(b.x)]) == gen, bar);
            __builtin_amdgcn_fence(__ATOMIC_ACQUIRE, "agent");
            asm volatile("s_waitcnt vmcnt(0)" ::: "memory");
        }
    }
    __syncthreads();
}

DEVI int tidx() { int t = threadIdx.x; asm volatile("" : "+v"(t)); return t; }
DEVI void ph_prologue(const Params& p, float* smem) {
    float* MOD = (float*)(p.ws + WS_MOD);
    const int tid = tidx(), w = tid >> 6, lane = tid & 63;
    for (int it = blockIdx.x; it < 4 * 48; it += gridDim.x) {
        const int layer = it / 48, n0 = (it % 48) * 128;
        const float* W = p.w_ada + (size_t)layer * 1024 * 6144 + n0 + 2 * lane;
        float* sv = smem; float* red = smem + 3 * 1024;
        __syncthreads();
        for (int i = tid; i < 3 * 1024; i += NTHR) { const int v = i >> 10, k = i & 1023; sv[i] = silu_(v == 0 ? p.c[k] : v == 1 ? p.c[1024 + k] : p.c_ctx[k]); }
        __syncthreads();
        f32x2 a0 = {0.f, 0.f}, a1 = {0.f, 0.f}, a2 = {0.f, 0.f};
#pragma unroll 8
        for (int kk = 0; kk < 128; ++kk) { const int k = w * 128 + kk; const f32x2 wv = *(const f32x2*)(W + (size_t)k * 6144);
            a0 += wv * sv[k]; a1 += wv * sv[1024 + k]; a2 += wv * sv[2048 + k]; }
        *(f32x2*)(red + (w * 3 + 0) * 128 + 2 * lane) = a0; *(f32x2*)(red + (w * 3 + 1) * 128 + 2 * lane) = a1; *(f32x2*)(red + (w * 3 + 2) * 128 + 2 * lane) = a2;
        __syncthreads();
        if (tid < 384) { const int v = tid >> 7, cidx = tid & 127; float sacc = p.b_ada[layer * 6144 + n0 + cidx];
#pragma unroll
            for (int ww = 0; ww < NWV; ++ww) sacc += red[(ww * 3 + v) * 128 + cidx];
            MOD[(size_t)(layer * 3 + v) * 6144 + n0 + cidx] = sacc; }
    }
    if (blockIdx.x == 0) {
        float* LB = (float*)(p.ws + WS_LB);
        for (int ch = tid; ch < 512; ch += NTHR) {
            const float p0 = p.hgrn_lb[ch], p1 = p.hgrn_lb[512 + ch], p2 = p.hgrn_lb[1024 + ch], p3 = p.hgrn_lb[1536 + ch];
            const float m = fmaxf(fmaxf(p0, p1), fmaxf(p2, p3));
            const float e0 = __expf(p0 - m), e1 = __expf(p1 - m), e2 = __expf(p2 - m), e3 = __expf(p3 - m), s = e0 + e1 + e2 + e3;
            LB[ch] = 0.f; LB[512 + ch] = e1 / s; LB[1024 + ch] = (e1 + e2) / s; LB[1536 + ch] = (e1 + e2 + e3) / s;
        }
        if (tid < 2) {
            const float* lv = p.diff_lambda + tid * 256; float d01 = 0.f, d23 = 0.f;
            for (int i = 0; i < 64; ++i) { d01 += lv[i] * lv[64 + i]; d23 += lv[128 + i] * lv[192 + i]; }
            const float lam_init = tid == 0 ? 0.2f : 0.47071301834f;
            ((float*)(p.ws + WS_LAM))[tid] = __expf(d01) - __expf(d23) + lam_init;
        }
    }
}

DEVI void ph_shq(const Params& p, float* smem) {
    const float* MOD = (const float*)(p.ws + WS_MOD); float* SHQ = (float*)(p.ws + WS_SHQ);
    const int tid = tidx(), w = tid >> 6, lane = tid & 63;
    for (int it = blockIdx.x; it < 4 * 16; it += gridDim.x) {
        const int layer = it >> 4, n0 = (it & 15) * 128;
        const float* W = p.peer_wq + (size_t)layer * 1024 * 2048 + n0 + 2 * lane;
        float* sv = smem; float* red = smem + 3 * 1024;
        __syncthreads();
        for (int i = tid; i < 3 * 1024; i += NTHR) sv[i] = MOD[(size_t)(layer * 3 + (i >> 10)) * 6144 + 3072 + (i & 1023)];
        __syncthreads();
        f32x2 a0 = {0.f, 0.f}, a1 = {0.f, 0.f}, a2 = {0.f, 0.f};
#pragma unroll 8
        for (int kk = 0; kk < 128; ++kk) { const int k = w * 128 + kk; const f32x2 wv = *(const f32x2*)(W + (size_t)k * 2048);
            a0 += wv * sv[k]; a1 += wv * sv[1024 + k]; a2 += wv * sv[2048 + k]; }
        *(f32x2*)(red + (w * 3 + 0) * 128 + 2 * lane) = a0; *(f32x2*)(red + (w * 3 + 1) * 128 + 2 * lane) = a1; *(f32x2*)(red + (w * 3 + 2) * 128 + 2 * lane) = a2;
        __syncthreads();
        if (tid < 384) { const int v = tid >> 7, cidx = tid & 127; float sacc = 0.f;
#pragma unroll
            for (int ww = 0; ww < NWV; ++ww) sacc += red[(ww * 3 + v) * 128 + cidx];
            SHQ[(size_t)(layer * 3 + v) * 2048 + n0 + cidx] = sacc; }
    }
}
DEVI void ph_norm(const Params& p, int layer, int which) {
    float* XA = (float*)(p.ws + WS_XA); bf16* H = (bf16*)(p.ws + WS_H); const float* MOD = (const float*)(p.ws + WS_MOD);
    const int lane = tidx() & 63, gw = blockIdx.x * NWV + (tidx() >> 6), NW = gridDim.x * NWV;
    const float* g = p.norm_g + (layer * 2 + which) * 1024;
    for (int r = gw; r < T; r += NW) {
        const f32x4* xr = (const f32x4*)(r < TX ? p.x + (size_t)r * 1024 : p.ctx + (size_t)(r - TX) * 1024);
        const float* m = MOD + (size_t)(layer * 3 + mod_index(r)) * 6144 + which * 3072;
        f32x4 v[4]; float ss = 0.f;
#pragma unroll
        for (int j = 0; j < 4; ++j) { v[j] = xr[j * 64 + lane]; ss += v[j].x * v[j].x + v[j].y * v[j].y + v[j].z * v[j].z + v[j].w * v[j].w; ((f32x4*)(XA + (size_t)r * 1024))[j * 64 + lane] = v[j]; }
        const float rstd = rsqrtf(wave_sum(ss) * (1.f / 1024.f) + EPS);
#pragma unroll
        for (int j = 0; j < 4; ++j) {
            const int col = (j * 64 + lane) * 4;
            const f32x4 g4 = *(const f32x4*)(g + col), sh = *(const f32x4*)(m + col), sc = *(const f32x4*)(m + 1024 + col);
            const f32x4 h = v[j] * rstd * g4 * (sc + 1.f) + sh;
            u32x2 o; o.x = pk2(h.x, h.y); o.y = pk2(h.z, h.w);
            *(u32x2*)(H + (size_t)r * 1024 + col) = o;
        }
    }
}

DEVI void ph_scan4(const Params& p, int layer) {
    const int jl = layer >> 1, lane = tidx() & 63, gw = blockIdx.x * NWV + (tidx() >> 6), NW = gridDim.x * NWV;
    const bf16* OFB = (const bf16*)(p.ws + WS_OFB); const bf16* G = (const bf16*)(p.ws + WS_G); bf16* OX = (bf16*)(p.ws + WS_OX);
    for (int r = gw; r < T; r += NW) {
#pragma unroll
        for (int j = 0; j < 4; ++j) {
            const int col = (j * 64 + lane) * 4, d = col & 127;
            const u32x2 of = *(const u32x2*)(OFB + (size_t)r * 1024 + col), ob = *(const u32x2*)(OFB + ((size_t)T + r) * 1024 + col);
            const f32x4 o = {bflo(of.x) + bflo(ob.x), bfhi(of.x) + bfhi(ob.x), bflo(of.y) + bflo(ob.y), bfhi(of.y) + bfhi(ob.y)};
            const u32x2 gg = *(const u32x2*)(G + (size_t)r * 1024 + col); const float g0 = bflo(gg.x), g1 = bfhi(gg.x), g2 = bflo(gg.y), g3 = bfhi(gg.y);
            f32x4 y;
            if (j < 2) {
                const f32x4 t = {o.x * sigmoid_(g0), o.y * sigmoid_(g1), o.z * sigmoid_(g2), o.w * sigmoid_(g3)};
                const float rn = rsqrtf(half_sum(t.x * t.x + t.y * t.y + t.z * t.z + t.w * t.w) * (1.f / 128.f) + EPS);
                const f32x4 gn = *(const f32x4*)(p.hgrn_gain + jl * 128 + d); y = t * rn * gn;
            } else {
                const float mean = half_sum(o.x + o.y + o.z + o.w) * (1.f / 128.f); const f32x4 dd = o - mean;
                const float rn = rsqrtf(half_sum(dd.x * dd.x + dd.y * dd.y + dd.z * dd.z + dd.w * dd.w) * (1.f / 128.f) + EPS);
                const f32x4 gn = *(const f32x4*)(p.ret_gain + jl * 128 + d); y = dd * rn * gn;
                y.x *= silu_(g0); y.y *= silu_(g1); y.z *= silu_(g2); y.w *= silu_(g3);
            }
            u32x2 w; w.x = pk2(y.x, y.y); w.y = pk2(y.z, y.w); *(u32x2*)(OX + (size_t)r * 1024 + col) = w;
        }
    }
}

#define KEY_INSERT(K, key) do { _Pragma("unroll") for (int _j = 15; _j >= 1; --_j) K[_j] = __builtin_amdgcn_fmed3f(K[_j - 1], K[_j], (key)); K[0] = fmaxf(K[0], (key)); } while (0)
typedef short bf16x8 __attribute__((ext_vector_type(8)));
constexpr size_t WT_INE = WS_WT, WT_INO = WS_WT + 10 * MiB, WT_OUT = WS_WT + 28 * MiB, WT_Q = WS_WT + 36 * MiB, WT_SK = WS_WT + 52 * MiB;

DEVI int perm_odd_col(int n) {
    const int blk = n >> 9; if (blk != 3 && blk != 7) return n;
    const int e = n & 127, sec = e >> 6, hlf = (e >> 5) & 1, i = e & 31; return (n & ~127) | (sec * 64 + (i >> 4) * 32 + hlf * 16 + (i & 15));
}
template <bool PERMODD> DEVI void transpose_item(const float* W, int K, int N, bf16* WT, float* scr, int item, int lane) {
    const int nblk = N / 32, kb = item / nblk, nb = item % nblk, k0 = 64 * kb, n0 = 32 * nb;
#pragma unroll 8
    for (int i = 0; i < 32; ++i) { const int kk = 2 * i + (lane >> 5); scr[kk * 33 + (lane & 31)] = W[(size_t)(k0 + kk) * N + n0 + (lane & 31)]; }
    asm volatile("s_waitcnt lgkmcnt(0)" ::: "memory"); __builtin_amdgcn_wave_barrier();
    const int c = lane & 7;
#pragma unroll
    for (int j = 0; j < 4; ++j) { const int n = (lane >> 3) + 8 * j; const float* s = scr + (8 * c) * 33 + n;
        u32x4 o; o.x = pk2(s[0 * 33], s[1 * 33]); o.y = pk2(s[2 * 33], s[3 * 33]); o.z = pk2(s[4 * 33], s[5 * 33]); o.w = pk2(s[6 * 33], s[7 * 33]);
        *(u32x4*)(WT + (size_t)(PERMODD ? perm_odd_col(n0 + n) : n0 + n) * K + k0 + 8 * c) = o; }
    asm volatile("s_waitcnt lgkmcnt(0)" ::: "memory"); __builtin_amdgcn_wave_barrier();
}
DEVI void ph_weights(const Params& p, float* smem) {
    const int wv = tidx() >> 6, lane = tidx() & 63, gw = blockIdx.x * NWV + wv, NW = gridDim.x * NWV;
    float* scr = smem + wv * (64 * 33);
    constexpr int I_E = 16 * (2560 / 32), I_O = 16 * (4608 / 32), I_W = 16 * (1024 / 32), I_Q = 16 * (2048 / 32);
    constexpr int NIT = 2 * I_E + 2 * I_O + 4 * I_W + 4 * I_Q;
    for (int it = gw; it < NIT; it += NW) {
        int r = it;
        if (r < 2 * I_E) { const int j = r / I_E; transpose_item<false>(p.w_in_even + (size_t)j * 1024 * 2560, 1024, 2560, (bf16*)(p.ws + WT_INE) + (size_t)j * 2560 * 1024, scr, r % I_E, lane); continue; } r -= 2 * I_E;
        if (r < 2 * I_O) { const int j = r / I_O; transpose_item<true>(p.w_in_odd + (size_t)j * 1024 * 4608, 1024, 4608, (bf16*)(p.ws + WT_INO) + (size_t)j * 4608 * 1024, scr, r % I_O, lane); continue; } r -= 2 * I_O;
        if (r < 4 * I_W) { const int j = r / I_W; transpose_item<false>(p.w_out + (size_t)j * 1024 * 1024, 1024, 1024, (bf16*)(p.ws + WT_OUT) + (size_t)j * 1024 * 1024, scr, r % I_W, lane); continue; } r -= 4 * I_W;
        { const int j = r / I_Q; transpose_item<false>(p.peer_wq + (size_t)j * 1024 * 2048, 1024, 2048, (bf16*)(p.ws + WT_Q) + (size_t)j * 2048 * 1024, scr, r % I_Q, lane); }
    }
}

constexpr int GEMM_BUF = 49152;
template <class Epi> DEVI void gemm_mfma(const bf16* A, const bf16* Wt, int N, unsigned char* lds, const Epi& epi, bool ctx_only) {
    const int tid = tidx(), wid = tid >> 6, lane = tid & 63, wr = wid >> 1, wc = wid & 1, fr = lane & 15, fq = lane >> 4;
    const int NT = N / 128;
    const int G = gridDim.x, nloc = G >> 3, xcd = blockIdx.x & 7, loc = blockIdx.x >> 3;
    const int bm = nloc >> 2, nmg = (64 + bm - 1) / bm, nng = NT >> 2, nmain = nmg * nng, nrounds = (nmain + 7) >> 3;
    int arow[4], ach[4], brow[2], bch[2];
#pragma unroll
    for (int i = 0; i < 4; ++i) { const int idx = tid + NTHR * i; arow[i] = idx >> 3; ach[i] = idx & 7; }
#pragma unroll
    for (int i = 0; i < 2; ++i) { const int idx = tid + NTHR * i; brow[i] = idx >> 3; bch[i] = idx & 7; }
    const int sw = fr & 7;
    for (int rd = ctx_only ? nrounds : 0; rd <= nrounds; ++rd) {
        int tm, tn;
        if (rd < nrounds) { const int sblk = rd * 8 + xcd; if (sblk >= nmain) continue; const int mg = sblk / nng, ng = sblk % nng; tm = mg * bm + (loc >> 2); tn = ng * 4 + (loc & 3); if (tm >= 64) continue; }
        else { const int t = G - 1 - (int)blockIdx.x; if (t >= 2 * NT) continue; tm = 64 + t / NT; tn = t % NT; }
        const int r0 = tm * 256, n0 = tn * 128;
        const bf16* Ag = A + (size_t)r0 * 1024; const bf16* Wg = Wt + (size_t)n0 * 1024;
        f32x4 acc[4][4];
#pragma unroll
        for (int a = 0; a < 4; ++a)
#pragma unroll
            for (int b = 0; b < 4; ++b) acc[a][b] = (f32x4){0.f, 0.f, 0.f, 0.f};
        u32x4 ra[4], rb[2];
#pragma unroll
        for (int i = 0; i < 4; ++i) ra[i] = *(const u32x4*)(Ag + (size_t)arow[i] * 1024 + ach[i] * 8);
#pragma unroll
        for (int i = 0; i < 2; ++i) rb[i] = *(const u32x4*)(Wg + (size_t)brow[i] * 1024 + bch[i] * 8);
        __syncthreads();
#pragma unroll
        for (int i = 0; i < 4; ++i) *(u32x4*)(lds + arow[i] * 128 + ((ach[i] ^ (arow[i] & 7)) << 4)) = ra[i];
#pragma unroll
        for (int i = 0; i < 2; ++i) *(u32x4*)(lds + 32768 + brow[i] * 128 + ((bch[i] ^ (brow[i] & 7)) << 4)) = rb[i];
        __syncthreads();
        for (int kt = 0; kt < 16; ++kt) {
            const int buf = kt & 1; unsigned char* la = lds + buf * GEMM_BUF; unsigned char* lb = la + 32768;
            if (kt + 1 < 16) {
#pragma unroll
                for (int i = 0; i < 4; ++i) ra[i] = *(const u32x4*)(Ag + (size_t)arow[i] * 1024 + (kt + 1) * 64 + ach[i] * 8);
#pragma unroll
                for (int i = 0; i < 2; ++i) rb[i] = *(const u32x4*)(Wg + (size_t)brow[i] * 1024 + (kt + 1) * 64 + bch[i] * 8);
            }
#pragma unroll
            for (int ks = 0; ks < 2; ++ks) {
                bf16x8 af[4], wf[4];
                const int ch = ((ks * 4 + fq) ^ sw) << 4;
#pragma unroll
                for (int m = 0; m < 4; ++m) af[m] = *(const bf16x8*)(la + (wr * 64 + m * 16 + fr) * 128 + ch);
#pragma unroll
                for (int n = 0; n < 4; ++n) wf[n] = *(const bf16x8*)(lb + (wc * 64 + n * 16 + fr) * 128 + ch);
#pragma unroll
                for (int m = 0; m < 4; ++m)
#pragma unroll
                    for (int n = 0; n < 4; ++n) acc[m][n] = __builtin_amdgcn_mfma_f32_16x16x32_bf16(wf[n], af[m], acc[m][n], 0, 0, 0);
            }
            if (kt + 1 < 16) {
                unsigned char* wa = lds + (buf ^ 1) * GEMM_BUF;
#pragma unroll
                for (int i = 0; i < 4; ++i) *(u32x4*)(wa + arow[i] * 128 + ((ach[i] ^ (arow[i] & 7)) << 4)) = ra[i];
#pragma unroll
                for (int i = 0; i < 2; ++i) *(u32x4*)(wa + 32768 + brow[i] * 128 + ((bch[i] ^ (brow[i] & 7)) << 4)) = rb[i];
            }
            __syncthreads();
        }
        epi(acc, r0 + wr * 64, n0 + wc * 64, fr, fq);
    }
}

template <int QTR> DEVI void rope_tile(f32x4 (&a)[4], int t, int sec128, int fq) {
    const int grow = t >> 6, gcol = t & 63;
    if (QTR == 16) {
#pragma unroll
        for (int s = 0; s < 2; ++s) { const float pos = (float)(s ? gcol : grow);
#pragma unroll
            for (int j = 0; j < 4; ++j) { const int i = fq * 4 + j; const float ang = pos * exp2f(-(float)i * (13.287712379549449f / 16.f)); const float cs = __cosf(ang), sn = __sinf(ang);
                const float x1 = a[2 * s][j], x2 = a[2 * s + 1][j]; a[2 * s][j] = x1 * cs - x2 * sn; a[2 * s + 1][j] = x1 * sn + x2 * cs; } }
    } else {
        const float pos = (float)(sec128 ? gcol : grow);
#pragma unroll
        for (int h = 0; h < 2; ++h)
#pragma unroll
            for (int j = 0; j < 4; ++j) { const int i = h * 16 + fq * 4 + j; const float ang = pos * exp2f(-(float)i * (13.287712379549449f / 32.f)); const float cs = __cosf(ang), sn = __sinf(ang);
                const float x1 = a[h][j], x2 = a[h + 2][j]; a[h][j] = x1 * cs - x2 * sn; a[h + 2][j] = x1 * sn + x2 * cs; }
    }
}
struct EpiEven {
    unsigned char* ws;
    DEVI void operator()(f32x4 (&acc)[4][4], int row0, int col0, int fr, int fq) const {
        const int blk = col0 >> 9, cc0 = col0 & 511;
        bf16* dst = (bf16*)(ws + (blk == 0 ? WS_KB : blk == 1 ? WS_VB : blk == 2 ? WS_UB : blk == 3 ? WS_VG : WS_QB));
#pragma unroll
        for (int m = 0; m < 4; ++m) {
            const int r = row0 + m * 16 + fr;
            if (blk == 0 || blk == 4) {
                if (r < TX) rope_tile<16>(acc[m], r & (SEQ - 1), 0, fq);
                if (blk == 4) {
#pragma unroll
                    for (int n = 0; n < 4; ++n) acc[m][n] = acc[m][n] * (DIFF_SCALE * LOG2E); }
            } else if (blk == 2 || blk == 3) {
#pragma unroll
                for (int n = 0; n < 4; ++n) { acc[m][n].x = gelu_(acc[m][n].x); acc[m][n].y = gelu_(acc[m][n].y); acc[m][n].z = gelu_(acc[m][n].z); acc[m][n].w = gelu_(acc[m][n].w); }
            }
#pragma unroll
            for (int n = 0; n < 4; ++n) *(u32x2*)(dst + (size_t)r * 512 + cc0 + n * 16 + fq * 4) = pk4(acc[m][n]);
        }
    }
};
struct EpiOdd {
    unsigned char* ws; const float* LB;
    DEVI void operator()(f32x4 (&acc)[4][4], int row0, int col0, int fr, int fq) const {
        const int blk = col0 >> 9, cc0 = col0 & 511;
#pragma unroll
        for (int m = 0; m < 4; ++m) {
            const int r = row0 + m * 16 + fr;
            if (blk <= 1) {
                float* LF = (float*)(ws + WS_LF) + ((size_t)blk * T + r) * 512 + cc0;
#pragma unroll
                for (int n = 0; n < 4; ++n) { const f32x4 lb = *(const f32x4*)(LB + cc0 + n * 16 + fq * 4); f32x4 o;
                    o.x = __logf(lb.x + (1.f - lb.x) * sigmoid_(acc[m][n].x)); o.y = __logf(lb.y + (1.f - lb.y) * sigmoid_(acc[m][n].y));
                    o.z = __logf(lb.z + (1.f - lb.z) * sigmoid_(acc[m][n].z)); o.w = __logf(lb.w + (1.f - lb.w) * sigmoid_(acc[m][n].w));
                    *(f32x4*)(LF + n * 16 + fq * 4) = o; }
            } else {
                bf16* dst; float sc = 1.f;
                switch (blk) {
                case 2: dst = (bf16*)(ws + WS_VS) + (size_t)r * 1024 + cc0; break;
                case 3: dst = (bf16*)(ws + WS_KR) + (size_t)r * 512 + cc0; sc = HEAD_SCALE; break;
                case 4: dst = (bf16*)(ws + WS_VS) + (size_t)r * 1024 + 512 + cc0; break;
                case 5: dst = (bf16*)(ws + WS_QS) + (size_t)r * 1024 + cc0; sc = HEAD_SCALE; break;
                case 6: dst = (bf16*)(ws + WS_G) + (size_t)r * 1024 + cc0; break;
                case 7: dst = (bf16*)(ws + WS_QS) + (size_t)r * 1024 + 512 + cc0; break;
                default: dst = (bf16*)(ws + WS_G) + (size_t)r * 1024 + 512 + cc0; break;
                }
                if (blk == 5) {
#pragma unroll
                    for (int n = 0; n < 4; ++n) { acc[m][n].x = silu_(acc[m][n].x); acc[m][n].y = silu_(acc[m][n].y); acc[m][n].z = silu_(acc[m][n].z); acc[m][n].w = silu_(acc[m][n].w); } }
#pragma unroll
                for (int n = 0; n < 4; ++n) *(u32x2*)(dst + ((blk == 3 || blk == 7) ? (n & 1) * 32 + (n >> 1) * 16 : n * 16) + fq * 4) = pk4(acc[m][n] * sc);
            }
        }
    }
};
struct EpiResid {
    float* XA; const float* gate; bf16* Hn; const float* ng; const float* sc; float* RSS;
    DEVI void operator()(f32x4 (&acc)[4][4], int row0, int col0, int fr, int fq) const {
        const int mi = mod_index(row0); const float* g = gate + (size_t)mi * 6144 + col0 + fq * 4; const float* s2 = sc + (size_t)mi * 6144 + col0 + fq * 4;
        float ss[4] = {0.f, 0.f, 0.f, 0.f};
#pragma unroll
        for (int n = 0; n < 4; ++n) { const f32x4 gv = *(const f32x4*)(g + n * 16); const f32x4 gam = *(const f32x4*)(ng + col0 + fq * 4 + n * 16) * (*(const f32x4*)(s2 + n * 16) + 1.f);
#pragma unroll
            for (int m = 0; m < 4; ++m) { const size_t o = (size_t)(row0 + m * 16 + fr) * 1024 + col0 + n * 16 + fq * 4; f32x4* xp = (f32x4*)(XA + o); const f32x4 x = *xp + gv * acc[m][n]; *xp = x;
                *(u32x2*)(Hn + o) = pk4(x * gam); ss[m] += x.x * x.x + x.y * x.y + x.z * x.z + x.w * x.w; } }
#pragma unroll
        for (int m = 0; m < 4; ++m) { float v = ss[m]; v += __shfl_xor(v, 16); v += __shfl_xor(v, 32); if (fq == 0) RSS[(size_t)(row0 + m * 16 + fr) * 16 + (col0 >> 6)] = v; }
    }
};
struct EpiBf16Out {
    bf16* O; int ld; const float* RSS; const float* shq;
    DEVI void operator()(f32x4 (&acc)[4][4], int row0, int col0, int fr, int fq) const {
        const float* sq = shq + (size_t)mod_index(row0) * 2048 + col0 + fq * 4;
#pragma unroll
        for (int m = 0; m < 4; ++m) { const float rs = rss_rstd(RSS + (size_t)(row0 + m * 16 + fr) * 16);
#pragma unroll
            for (int n = 0; n < 4; ++n) *(u32x2*)(O + (size_t)(row0 + m * 16 + fr) * ld + col0 + n * 16 + fq * 4) = pk4(acc[m][n] * rs + *(const f32x4*)(sq + n * 16)); }
    }
};

typedef float f32x16 __attribute__((ext_vector_type(16)));
typedef short s16x4 __attribute__((ext_vector_type(4)));
#define KSWZ(row, colB) ((row) * 256 + ((colB) ^ (((row) & 7) << 4)))
#define SBAR() __builtin_amdgcn_sched_barrier(0)
constexpr int SHM_V = 64 * 128 * 2, SHM_K = 64 * 128 * 2;
constexpr float ATT_THR = 8.f;
DEVI int crow(int r, int hi) { return (r & 3) + 8 * (r >> 2) + 4 * hi; }
DEVI unsigned cvtpk(float lo, float hi) { unsigned r; asm volatile("v_cvt_pk_bf16_f32 %0, %1, %2" : "=v"(r) : "v"(lo), "v"(hi)); return r; }
DEVI bf16 f2bf_hw(float x) { return __builtin_bit_cast(unsigned short, (__bf16)x); }
DEVI void partialSM(f32x16& p0, f32x16& p1, float& m_reg, float& mn, float& alpha) {
    float pmax = p0[0];
#pragma unroll
    for (int r = 1; r < 16; ++r) pmax = fmaxf(pmax, p0[r]);
#pragma unroll
    for (int r = 0; r < 16; ++r) pmax = fmaxf(pmax, p1[r]);
    { auto rr = __builtin_amdgcn_permlane32_swap(__float_as_uint(pmax), __float_as_uint(pmax), false, false);
      pmax = fmaxf(__uint_as_float(rr[0]), __uint_as_float(rr[1])); }
    if (__builtin_expect(__all(pmax - m_reg <= ATT_THR), 1)) { mn = m_reg; alpha = 1.f; }
    else { mn = fmaxf(m_reg, pmax); alpha = __builtin_amdgcn_exp2f(m_reg - mn); m_reg = mn; }
#pragma unroll
    for (int r = 0; r < 16; ++r) { p0[r] -= mn; p1[r] -= mn; }
#pragma unroll
    for (int r = 0; r < 16; ++r) p0[r] = __builtin_amdgcn_exp2f(p0[r]);
}
DEVI void finishSM(f32x16& p0, f32x16& p1, float alpha, float& l_reg, bf16x8& pa0, bf16x8& pa1, bf16x8& pa2, bf16x8& pa3) {
#pragma unroll
    for (int r = 0; r < 16; ++r) p1[r] = __builtin_amdgcn_exp2f(p1[r]);
    float ps = 0.f;
#pragma unroll
    for (int r = 0; r < 16; ++r) ps += p0[r];
#pragma unroll
    for (int r = 0; r < 16; ++r) ps += p1[r];
    { auto rr = __builtin_amdgcn_permlane32_swap(__float_as_uint(ps), __float_as_uint(ps), false, false);
      ps = __uint_as_float(rr[0]) + __uint_as_float(rr[1]); }
    l_reg = l_reg * alpha + ps;
#define PK4(P, BASE, OUT) do { unsigned a0 = cvtpk(P[BASE + 0], P[BASE + 1]), a1 = cvtpk(P[BASE + 2], P[BASE + 3]);   \
    unsigned b0 = cvtpk(P[BASE + 4], P[BASE + 5]), b1 = cvtpk(P[BASE + 6], P[BASE + 7]);                              \
    auto r0 = __builtin_amdgcn_permlane32_swap(a0, b0, false, false); auto r1 = __builtin_amdgcn_permlane32_swap(a1, b1, false, false); \
    u32x4 w = {r0[0], r1[0], r0[1], r1[1]}; OUT = *reinterpret_cast<bf16x8*>(&w); } while (0)
    PK4(p0, 0, pa0); PK4(p0, 8, pa1); PK4(p1, 0, pa2); PK4(p1, 8, pa3);
#undef PK4
}
DEVI void qkt(f32x16& p0, f32x16& p1, const unsigned char* Ks, const bf16x8* qr, int r32, int hi, int cb0) {
    p0 = f32x16{}; p1 = f32x16{};
#pragma unroll
    for (int d0 = 0; d0 < 4; ++d0) { const int cb = cb0 + (d0 * 16 + hi * 8) * 2;
        const bf16x8 b0 = *reinterpret_cast<const bf16x8*>(Ks + KSWZ(r32, cb));
        const bf16x8 b1 = *reinterpret_cast<const bf16x8*>(Ks + KSWZ(32 + r32, cb));
        p0 = __builtin_amdgcn_mfma_f32_32x32x16_bf16(b0, qr[d0], p0, 0, 0, 0);
        p1 = __builtin_amdgcn_mfma_f32_32x32x16_bf16(b1, qr[d0], p1, 0, 0, 0); }
}
DEVI int v_st(int k, int c) { const int kk = (k & ~0xC) | ((k & 4) << 1) | ((k & 8) >> 1); return ((kk >> 3) * 4 + (c >> 5)) * 512 + ((kk & 7) * 32 + (c & 31)) * 2; }
DEVI int v_rd_base(int lane) { return ((lane & 3) << 3) | (((lane >> 2) & 3) << 6) | (((lane >> 4) & 1) << 5) | (((lane >> 5) & 1) << 8); }
constexpr int v_rd_off(int d0, int ks, int half) { return d0 * 512 + ks * 4096 + half * 2048; }
template <int OFF> DEVI s16x4 tr_read(int vb) { s16x4 r; asm volatile("ds_read_b64_tr_b16 %0, %1 offset:%2" : "=&v"(r) : "v"(vb), "i"(OFF) : "memory"); return r; }
template <int D0> DEVI void pv_one(f32x16& od, int vb, bf16x8 pa0, bf16x8 pa1, bf16x8 pa2, bf16x8 pa3) {
    const s16x4 l0 = tr_read<v_rd_off(D0, 0, 0)>(vb), h0 = tr_read<v_rd_off(D0, 0, 1)>(vb), l1 = tr_read<v_rd_off(D0, 1, 0)>(vb), h1 = tr_read<v_rd_off(D0, 1, 1)>(vb);
    const s16x4 l2 = tr_read<v_rd_off(D0, 2, 0)>(vb), h2 = tr_read<v_rd_off(D0, 2, 1)>(vb), l3 = tr_read<v_rd_off(D0, 3, 0)>(vb), h3 = tr_read<v_rd_off(D0, 3, 1)>(vb);
    asm volatile("s_waitcnt lgkmcnt(0)" ::: "memory"); SBAR();
#define PKV(L, H) (bf16x8){L[0], L[1], L[2], L[3], H[0], H[1], H[2], H[3]}
    od = __builtin_amdgcn_mfma_f32_32x32x16_bf16(pa0, PKV(l0, h0), od, 0, 0, 0);
    od = __builtin_amdgcn_mfma_f32_32x32x16_bf16(pa1, PKV(l1, h1), od, 0, 0, 0);
    od = __builtin_amdgcn_mfma_f32_32x32x16_bf16(pa2, PKV(l2, h2), od, 0, 0, 0);
    od = __builtin_amdgcn_mfma_f32_32x32x16_bf16(pa3, PKV(l3, h3), od, 0, 0, 0);
#undef PKV
}
DEVI void pv_d0(f32x16* o, int vb, bf16x8 pa0, bf16x8 pa1, bf16x8 pa2, bf16x8 pa3) {
    pv_one<0>(o[0], vb, pa0, pa1, pa2, pa3); pv_one<1>(o[1], vb, pa0, pa1, pa2, pa3); pv_one<2>(o[2], vb, pa0, pa1, pa2, pa3); pv_one<3>(o[3], vb, pa0, pa1, pa2, pa3);
}
DEVI void attn_unit(const Params& p, int jl, int b, int h, int q0row, int nxt, int NT, unsigned char* lds, float lam, float lam_init) {
    const int tid = tidx(), wid = tid >> 6, lane = tid & 63, r32 = lane & 31, hi = lane >> 5, rg = wid >> 1, st = wid & 1;
    const bf16* QB = (const bf16*)(p.ws + WS_QB); const bf16* KB = (const bf16*)(p.ws + WS_KB); const bf16* VB = (const bf16*)(p.ws + WS_VB); bf16* OX = (bf16*)(p.ws + WS_OX);
    unsigned char* V_lds = lds; unsigned char* K_lds = lds + 2 * SHM_V;
    float* wsl = (float*)(lds + 2 * SHM_V + 2 * SHM_K) + wid * 64; float* li_l = wsl; float* al_l = wsl + 32;
    float m_reg = -1e30f, l_reg = 0.f; f32x16 o[4] = {}; bf16x8 qr[4];
    { const bf16* Qw = QB + (size_t)(q0row + rg * 32 + r32) * 512 + h * 128 + st * 64 + hi * 8;
#pragma unroll
      for (int d0 = 0; d0 < 4; ++d0) qr[d0] = *reinterpret_cast<const bf16x8*>(Qw + d0 * 16); }
    const int cb0 = st * 128;
    const int sr = tid >> 4, sc = (tid & 15) * 8, vst0 = v_st(sr, sc), vst1 = v_st(32 + sr, sc);
    const int vb0 = (int)(uintptr_t)V_lds + v_rd_base(lane);
    const bf16* Kx = KB + (size_t)(b * SEQ) * 512 + h * 128; const bf16* Kc = KB + (size_t)(TX + b * NCTX) * 512 + h * 128;
    const bf16* Vx = VB + (size_t)(b * SEQ) * 512 + h * 128; const bf16* Vc = VB + (size_t)(TX + b * NCTX) * 512 + h * 128;
    struct { bf16x8 vs0, vs1, ks0, ks1; } sr_[2];
#define TROW(j) ((j) < nxt ? (size_t)(j) * 64 : (size_t)((j) - nxt) * 64)
#define SLOAD(i, j) do { const bool inx_ = (j) < nxt; const bf16* Kh_ = (inx_ ? Kx : Kc) + TROW(j) * 512; const bf16* Vh_ = (inx_ ? Vx : Vc) + TROW(j) * 512; \
    sr_[i].vs0 = *(const bf16x8*)(Vh_ + (size_t)sr * 512 + sc); sr_[i].vs1 = *(const bf16x8*)(Vh_ + (size_t)(32 + sr) * 512 + sc); \
    sr_[i].ks0 = *(const bf16x8*)(Kh_ + (size_t)sr * 512 + sc); sr_[i].ks1 = *(const bf16x8*)(Kh_ + (size_t)(32 + sr) * 512 + sc); } while (0)
#define SWRITE(bb, i) do { *(bf16x8*)(V_lds + (bb) * SHM_V + vst0) = sr_[i].vs0; *(bf16x8*)(V_lds + (bb) * SHM_V + vst1) = sr_[i].vs1; const int kc = sc * 2; \
    *(bf16x8*)(K_lds + (bb) * SHM_K + KSWZ(sr, kc)) = sr_[i].ks0; *(bf16x8*)(K_lds + (bb) * SHM_K + KSWZ(32 + sr, kc)) = sr_[i].ks1; } while (0)
#define SWAIT() asm volatile("s_waitcnt vmcnt(4)" ::: "memory")
#define RESC(a) do { if (__any((a) < 1.f)) { if (hi == 0) al_l[r32] = (a); asm volatile("s_waitcnt lgkmcnt(0)" ::: "memory"); \
    _Pragma("unroll") for (int d = 0; d < 4; ++d) _Pragma("unroll") for (int r = 0; r < 16; ++r) o[d][r] *= al_l[crow(r, hi)]; } } while (0)
    f32x16 pA0, pA1, pB0, pB1; float mnA, mnB, alA, alB; bf16x8 pa0, pa1, pa2, pa3;
    constexpr int SE = 0, SO = 1;
    __syncthreads();
    SLOAD(SE, 0); asm volatile("s_waitcnt vmcnt(0)" ::: "memory"); SWRITE(0, SE); __syncthreads();
    qkt(pA0, pA1, K_lds, qr, r32, hi, cb0); partialSM(pA0, pA1, m_reg, mnA, alA);
    SLOAD(SO, 1); if (2 < NT) SLOAD(SE, 2);
    SWAIT(); SWRITE(1, SO); __syncthreads();
    for (int j = 1; j + 1 < NT; j += 2) {
        SBAR(); qkt(pB0, pB1, K_lds + SHM_K, qr, r32, hi, cb0);
        finishSM(pA0, pA1, alA, l_reg, pa0, pa1, pa2, pa3); SBAR();
        SLOAD(SO, j + 2); SBAR();
        pv_d0(o, vb0, pa0, pa1, pa2, pa3); partialSM(pB0, pB1, m_reg, mnB, alB);
        __syncthreads(); SWAIT(); SWRITE(0, SE);
        RESC(alB); __syncthreads();
        SBAR(); qkt(pA0, pA1, K_lds, qr, r32, hi, cb0);
        finishSM(pB0, pB1, alB, l_reg, pa0, pa1, pa2, pa3); SBAR();
        if (j + 3 < NT) SLOAD(SE, j + 3); SBAR();
        pv_d0(o, vb0 + SHM_V, pa0, pa1, pa2, pa3); partialSM(pA0, pA1, m_reg, mnA, alA);
        __syncthreads(); SWAIT(); SWRITE(1, SO);
        RESC(alA); __syncthreads();
    }
    SBAR(); qkt(pB0, pB1, K_lds + SHM_K, qr, r32, hi, cb0);
    finishSM(pA0, pA1, alA, l_reg, pa0, pa1, pa2, pa3); SBAR();
    pv_d0(o, vb0, pa0, pa1, pa2, pa3); partialSM(pB0, pB1, m_reg, mnB, alB);
    __syncthreads(); RESC(alB);
    finishSM(pB0, pB1, alB, l_reg, pa0, pa1, pa2, pa3); SBAR();
    pv_d0(o, vb0 + SHM_V, pa0, pa1, pa2, pa3);
    if (hi == 0) li_l[r32] = l_reg;
    asm volatile("s_waitcnt lgkmcnt(0)" ::: "memory");
    float rli[16];
#pragma unroll
    for (int r = 0; r < 16; ++r) rli[r] = __builtin_amdgcn_rcpf(li_l[crow(r, hi)]);
    __syncthreads();
    float* X = (float*)lds + rg * (32 * 128);
    if (st == 1) {
#pragma unroll
        for (int r = 0; r < 16; ++r)
#pragma unroll
            for (int d0 = 0; d0 < 4; ++d0) X[crow(r, hi) * 128 + d0 * 32 + r32] = o[d0][r] * rli[r] * lam;
    }
    __syncthreads();
    if (st == 0) {
        float ss[16];
#pragma unroll
        for (int r = 0; r < 16; ++r) { float s2 = 0.f;
#pragma unroll
            for (int d0 = 0; d0 < 4; ++d0) { const float v = o[d0][r] * rli[r] - X[crow(r, hi) * 128 + d0 * 32 + r32]; o[d0][r] = v; s2 += v * v; }
            ss[r] = s2; }
#pragma unroll
        for (int off = 16; off >= 1; off >>= 1)
#pragma unroll
            for (int r = 0; r < 16; ++r) ss[r] += __shfl_xor(ss[r], off);
        float gn[4];
#pragma unroll
        for (int d0 = 0; d0 < 4; ++d0) gn[d0] = p.diff_sub_gain[jl * 128 + d0 * 32 + r32] * (1.f - lam_init);
#pragma unroll
        for (int r = 0; r < 16; ++r) { const float rn = rsqrtf(ss[r] * (1.f / 128.f) + EPS); bf16* orow = OX + (size_t)(q0row + rg * 32 + crow(r, hi)) * 1024 + 512 + h * 128 + r32;
#pragma unroll
            for (int d0 = 0; d0 < 4; ++d0) orow[d0 * 32] = (bf16)f2bf(o[d0][r] * rn * gn[d0]); }
    }
#undef TROW
#undef SLOAD
#undef SWRITE
#undef SWAIT
#undef RESC
}
DEVI void ph_attn(const Params& p, int layer, unsigned char* lds) {
    const int jl = layer >> 1; const float lam = ((const float*)(p.ws + WS_LAM))[jl], lam_init = jl == 0 ? 0.2f : 0.47071301834f;
    const int G = gridDim.x, nloc = G >> 3, xcd = blockIdx.x & 7, loc = blockIdx.x >> 3, b = xcd >> 2, h = xcd & 3;
    for (int u = loc; u < 66; u += nloc) {
        if (u < 64) attn_unit(p, jl, b, h, b * SEQ + u * 128, 128, NCHUNK, lds, lam, lam_init);
        else attn_unit(p, jl, b, h, TX + b * NCTX + (u - 64) * 128, 0, 4, lds, lam, lam_init);
    }
}

typedef float f32x16v __attribute__((ext_vector_type(16)));
typedef float f32x32v __attribute__((ext_vector_type(32)));
typedef unsigned u32x6 __attribute__((ext_vector_type(6)));
constexpr size_t TAB_V = 12 * MiB, TAB_SCL = 24 * MiB;
DEVI void ph_tables(const Params& p, int layer, int b0, int nb) {
    if ((int)blockIdx.x < b0 || (int)blockIdx.x >= b0 + nb) return;
    const int tid = tidx(), lane = tid & 63, g = lane & 31, hf = lane >> 5, gw = ((int)blockIdx.x - b0) * NWV + (tid >> 6), NW = nb * NWV;
    float* SCL = (float*)(p.ws + WS_TAB + TAB_SCL);
    for (int rp = gw; rp < 16384; rp += NW) {
        const int row = 2 * rp + hf, tab = row >> 14, e = row & 16383;
        const f32x4* src = (const f32x4*)((tab ? p.peer_v : p.peer_u) + ((size_t)layer * 16384 + e) * 1024 + 32 * g);
        f32x4 x[8]; float am = 0.f;
#pragma unroll
        for (int i = 0; i < 8; ++i) { x[i] = src[i]; am = fmaxf(am, fmaxf(fmaxf(fabsf(x[i].x), fabsf(x[i].y)), fmaxf(fabsf(x[i].z), fabsf(x[i].w)))); }
        am = fmaxf(am, __shfl_xor(am, 16)); am = fmaxf(am, __shfl_xor(am, 8)); am = fmaxf(am, __shfl_xor(am, 4)); am = fmaxf(am, __shfl_xor(am, 2)); am = fmaxf(am, __shfl_xor(am, 1));
        const float e2 = am > 0.f ? floorf(log2f(7.5f / am)) : 0.f; const float sc = exp2f(e2);
        f32x16v a, bb;
#pragma unroll
        for (int i = 0; i < 8; ++i) { a[2 * i] = x[i].x * sc; bb[2 * i] = x[i].y * sc; a[2 * i + 1] = x[i].z * sc; bb[2 * i + 1] = x[i].w * sc; }
        const u32x6 w = __builtin_amdgcn_cvt_scalef32_2xpk16_fp6_f32(a, bb, 1.0f);
        unsigned char* dst = p.ws + WS_TAB + (size_t)tab * TAB_V + (size_t)e * 768 + 8 * g;
        *(u32x2*)dst = (u32x2){w[0], w[1]}; *(u32x2*)(dst + 256) = (u32x2){w[2], w[3]}; *(u32x2*)(dst + 512) = (u32x2){w[4], w[5]};
        if (g == 0) SCL[row] = exp2f(-e2);
    }
}
#define GAS __attribute__((address_space(1)))
DEVI u32x2 gld8(const unsigned char* p) { return *(const GAS u32x2*)p; }
DEVI float row16_sum(float d) {
    d += __builtin_bit_cast(float, __builtin_amdgcn_update_dpp(0, __builtin_bit_cast(int, d), 0xB1, 0xF, 0xF, true));
    d += __builtin_bit_cast(float, __builtin_amdgcn_update_dpp(0, __builtin_bit_cast(int, d), 0x4E, 0xF, 0xF, true));
    d += __builtin_bit_cast(float, __builtin_amdgcn_update_dpp(0, __builtin_bit_cast(int, d), 0x141, 0xF, 0xF, true));
    d += __builtin_bit_cast(float, __builtin_amdgcn_update_dpp(0, __builtin_bit_cast(int, d), 0x140, 0xF, 0xF, true));
    return d;
}
DEVI float gelu_fast(float x) { const float u = 1.5957691216057308f * (x + 0.044715f * x * x * x); return x * __builtin_amdgcn_rcpf(1.f + __expf(-u)); }
#if defined(PROF_STEP)
#define GNJ 1
#else
#define GNJ 2
#endif
template <bool DRY> DEVI void ph_peer_gather(const Params& p, int layer, float* smem) {
    const bf16* H = (const bf16*)(p.ws + WS_H); float* XA = (float*)(p.ws + WS_XA); const int* EID = (const int*)(p.ws + WS_EID); const float* GATE = (const float*)(p.ws + WS_GATE);
    const float* MOD = (const float*)(p.ws + WS_MOD);
    const unsigned char* TU = p.ws + WS_TAB; const unsigned char* TV = p.ws + WS_TAB + TAB_V; const float* SCL = (const float*)(p.ws + WS_TAB + TAB_SCL);
    const int tid = tidx(), lane = tid & 63, g = lane & 31, hf = lane >> 5, gw = blockIdx.x * NWV + (tid >> 6), NW = gridDim.x * NWV, nrow = layer == DEPTH - 1 ? TX : T;
    const bool last = layer == DEPTH - 1;
    const int nmain = (nrow / NW) * NW, ntail = nrow - nmain, split = (ntail > 0 && ntail * 4 == NW) ? 1 : 0, nitem = nmain / NW + (ntail > 0 ? 1 : 0);
    for (int itx = 0; itx < nitem; ++itx) {
        const bool tailq = split && itx == nmain / NW;
        const int r = tailq ? nmain + (gw >> 2) : gw + itx * NW; const int s0 = tailq ? (gw & 3) * 32 : 0, s1 = tailq ? s0 + 32 : 128;
        if (!tailq && r >= nrow) continue;
        float hv[32];
        { const u32x4* hp = (const u32x4*)(H + (size_t)r * 1024 + 32 * g); const float rs2 = rss_rstd((const float*)(p.ws + WS_RSS) + ((size_t)layer * T + r) * 16);
          const float* sh2 = MOD + (size_t)(layer * 3 + mod_index(r)) * 6144 + 3072 + 32 * g;
#pragma unroll
          for (int i = 0; i < 4; ++i) { const u32x4 a = hp[i]; const f32x4 s0 = *(const f32x4*)(sh2 + 8 * i), s1 = *(const f32x4*)(sh2 + 8 * i + 4);
              hv[8 * i] = bflo(a.x) * rs2 + s0.x; hv[8 * i + 1] = bfhi(a.x) * rs2 + s0.y; hv[8 * i + 2] = bflo(a.y) * rs2 + s0.z; hv[8 * i + 3] = bfhi(a.y) * rs2 + s0.w;
              hv[8 * i + 4] = bflo(a.z) * rs2 + s1.x; hv[8 * i + 5] = bfhi(a.z) * rs2 + s1.y; hv[8 * i + 6] = bflo(a.w) * rs2 + s1.z; hv[8 * i + 7] = bfhi(a.w) * rs2 + s1.w; } }
        float acc[32];
#pragma unroll
        for (int i = 0; i < 32; ++i) acc[i] = 0.f;
        const int E0 = EID[(size_t)r * 128 + lane], E1 = EID[(size_t)r * 128 + 64 + lane];
        const float G0 = GATE[(size_t)r * 128 + lane], G1 = GATE[(size_t)r * 128 + 64 + lane];
        u32x2 uA[GNJ][3], vA[GNJ][3], uB[GNJ][3], vB[GNJ][3]; float guA[GNJ], gvA[GNJ], guB[GNJ], gvB[GNJ];
#define G_LOAD(UU, VV, GU, GV, e0_) do { _Pragma("unroll") for (int j = 0; j < GNJ; ++j) { const int sl = (e0_) + 2 * j, li = sl & 63; const int Es = sl < 64 ? E0 : E1; const float Gs = sl < 64 ? G0 : G1; \
            const int ea = __builtin_amdgcn_readlane(Es, li), eb = __builtin_amdgcn_readlane(Es, li + 1); const float ga = __builtin_bit_cast(float, __builtin_amdgcn_readlane(__builtin_bit_cast(int, Gs), li)), gb = __builtin_bit_cast(float, __builtin_amdgcn_readlane(__builtin_bit_cast(int, Gs), li + 1)); \
            const int eid = hf ? eb : ea; GU[j] = SCL[eid]; GV[j] = (hf ? gb : ga) * SCL[16384 + eid]; \
            const unsigned char* up = TU + (size_t)eid * 768 + 8 * g; const unsigned char* vp = TV + (size_t)eid * 768 + 8 * g; \
            _Pragma("unroll") for (int w = 0; w < 3; ++w) { UU[j][w] = gld8(up + 256 * w); VV[j][w] = gld8(vp + 256 * w); } } } while (0)
#define G_USE(UU, VV, GU, GV) do { _Pragma("unroll") for (int j = 0; j < GNJ; ++j) { \
            const f32x32v fu = __builtin_amdgcn_cvt_scalef32_pk32_f32_fp6((u32x6){UU[j][0].x, UU[j][0].y, UU[j][1].x, UU[j][1].y, UU[j][2].x, UU[j][2].y}, 1.0f); \
            float d0 = 0.f, d1 = 0.f, d2 = 0.f, d3 = 0.f; _Pragma("unroll") for (int i = 0; i < 32; i += 4) { d0 += hv[i] * fu[i]; d1 += hv[i + 1] * fu[i + 1]; d2 += hv[i + 2] * fu[i + 2]; d3 += hv[i + 3] * fu[i + 3]; } \
            float d = row16_sum((d0 + d1) + (d2 + d3)); d += __shfl_xor(d, 16); \
            const float coef = GV[j] * gelu_fast(d * GU[j]); \
            const f32x32v fv = __builtin_amdgcn_cvt_scalef32_pk32_f32_fp6((u32x6){VV[j][0].x, VV[j][0].y, VV[j][1].x, VV[j][1].y, VV[j][2].x, VV[j][2].y}, 1.0f); \
            _Pragma("unroll") for (int i = 0; i < 32; ++i) acc[i] += coef * fv[i]; } } while (0)
        G_LOAD(uA, vA, guA, gvA, s0);
        for (int e0 = s0; e0 < s1; e0 += 4 * GNJ) {
            G_LOAD(uB, vB, guB, gvB, e0 + 2 * GNJ);
            G_USE(uA, vA, guA, gvA);
            if (e0 + 4 * GNJ < s1) G_LOAD(uA, vA, guA, gvA, e0 + 4 * GNJ);
            G_USE(uB, vB, guB, gvB);
        }
#undef G_LOAD
#undef G_USE
        float o[16];
#pragma unroll
        for (int i = 0; i < 16; ++i) { const float mine = hf ? acc[16 + i] : acc[i], send = hf ? acc[i] : acc[16 + i]; o[i] = mine + __shfl_xor(send, 32); }
        const int col0 = 32 * g + 16 * hf;
        if (tailq) {
            const int wq = gw & 3, wgp = (tid >> 6) >> 2; float* X = smem + (wgp * 4) * 1024;
            __syncthreads();
#pragma unroll
            for (int i = 0; i < 16; i += 4) *(f32x4*)(X + wq * 1024 + col0 + i) = (f32x4){o[i], o[i + 1], o[i + 2], o[i + 3]};
            __syncthreads();
            if (wq != 0) continue;
#pragma unroll
            for (int i = 0; i < 16; i += 4) { const f32x4 a = *(const f32x4*)(X + col0 + i), b2 = *(const f32x4*)(X + 1024 + col0 + i), c2 = *(const f32x4*)(X + 2048 + col0 + i), d2 = *(const f32x4*)(X + 3072 + col0 + i);
                o[i] = (a.x + b2.x) + (c2.x + d2.x); o[i + 1] = (a.y + b2.y) + (c2.y + d2.y); o[i + 2] = (a.z + b2.z) + (c2.z + d2.z); o[i + 3] = (a.w + b2.w) + (c2.w + d2.w); }
        }
        const float* g2 = MOD + (size_t)(layer * 3 + mod_index(r)) * 6144 + 5120 + col0;
        float* xr = XA + (size_t)r * 1024 + col0;
        f32x4 x[4];
#pragma unroll
        for (int q = 0; q < 4; ++q) { const f32x4 gg = *(const f32x4*)(g2 + 4 * q);
            x[q] = *(const f32x4*)(xr + 4 * q); x[q].x += gg.x * o[q * 4 + 0]; x[q].y += gg.y * o[q * 4 + 1]; x[q].z += gg.z * o[q * 4 + 2]; x[q].w += gg.w * o[q * 4 + 3]; }
        float ss = 0.f;
#pragma unroll
        for (int q = 0; q < 4; ++q) ss += x[q].x * x[q].x + x[q].y * x[q].y + x[q].z * x[q].z + x[q].w * x[q].w;
        const float rstd = rsqrtf(wave_sum(ss) * (1.f / 1024.f) + EPS);
        if (DRY) { if (x[0].x == 1.2345e30f) xr[0] = x[1].x + x[2].y + x[3].z; }
        else if (!last) {
            const float* gN = p.norm_g + (layer + 1) * 2 * 1024 + col0; const float* mN = MOD + (size_t)((layer + 1) * 3 + mod_index(r)) * 6144 + col0;
            bf16* hr = (bf16*)(p.ws + WS_H) + (size_t)r * 1024 + col0;
#pragma unroll
            for (int q = 0; q < 4; ++q) { *(f32x4*)(xr + 4 * q) = x[q];
                const f32x4 g4 = *(const f32x4*)(gN + 4 * q), sh = *(const f32x4*)(mN + 4 * q), sc = *(const f32x4*)(mN + 1024 + 4 * q);
                *(u32x2*)(hr + 4 * q) = pk4(x[q] * rstd * g4 * (sc + 1.f) + sh); }
        } else {
#pragma unroll
            for (int q = 0; q < 4; ++q) *(f32x4*)(p.out + (size_t)r * 1024 + col0 + 4 * q) = x[q] * rstd * *(const f32x4*)(p.final_g + col0 + 4 * q);
        }
    }
}


#if defined(PROF_GDRY)
DEVI void ph_gather_dry(const Params& p, int layer) {
    const int* EID = (const int*)(p.ws + WS_EID); float* XA = (float*)(p.ws + WS_XA);
    const unsigned char* TU = p.ws + WS_TAB; const unsigned char* TV = p.ws + WS_TAB + TAB_V;
    const int tid = tidx(), lane = tid & 63, gw = blockIdx.x * NWV + (tid >> 6), NW = gridDim.x * NWV, nrow = layer == DEPTH - 1 ? TX : T;
    for (int r = gw; r < nrow; r += NW) {
        unsigned sum = 0u;
#if PROF_GDRY == 1
        const int g = lane & 31, hf = lane >> 5; const int* er = EID + (size_t)r * 128 + hf;
        for (int e0 = 0; e0 < 128; e0 += 8) {
            u32x2 uu[4][3], vv[4][3];
#pragma unroll
            for (int j = 0; j < 4; ++j) { const int eid = er[e0 + 2 * j];
#pragma unroll
                for (int w = 0; w < 3; ++w) { uu[j][w] = *(const u32x2*)(TU + (size_t)eid * 768 + 8 * g + 256 * w); vv[j][w] = *(const u32x2*)(TV + (size_t)eid * 768 + 8 * g + 256 * w); } }
#pragma unroll
            for (int j = 0; j < 4; ++j)
#pragma unroll
                for (int w = 0; w < 3; ++w) sum += uu[j][w].x ^ uu[j][w].y ^ vv[j][w].x ^ vv[j][w].y;
        }
#elif PROF_GDRY == 2
        const int* er = EID + (size_t)r * 128;
        for (int e0 = 0; e0 < 128; e0 += 8) {
            u32x4 uu[8], vv[8];
#pragma unroll
            for (int j = 0; j < 8; ++j) { const int eid = __builtin_amdgcn_readfirstlane(er[e0 + j]); const int l = lane < 48 ? lane : 47;
                uu[j] = *(const u32x4*)(TU + (size_t)eid * 768 + 16 * l); vv[j] = *(const u32x4*)(TV + (size_t)eid * 768 + 16 * l); }
#pragma unroll
            for (int j = 0; j < 8; ++j) sum += uu[j].x ^ uu[j].y ^ uu[j].z ^ uu[j].w ^ vv[j].x ^ vv[j].y ^ vv[j].z ^ vv[j].w;
        }
#else
        const int t16 = lane & 15, q = lane >> 4; const int* er = EID + (size_t)r * 128 + q;
        for (int e0 = 0; e0 < 128; e0 += 16) {
            u32x4 uu[4][3], vv[4][3];
#pragma unroll
            for (int j = 0; j < 4; ++j) { const int eid = er[e0 + 4 * j];
#pragma unroll
                for (int w = 0; w < 3; ++w) { uu[j][w] = *(const u32x4*)(TU + (size_t)eid * 768 + 16 * t16 + 256 * w); vv[j][w] = *(const u32x4*)(TV + (size_t)eid * 768 + 16 * t16 + 256 * w); } }
#pragma unroll
            for (int j = 0; j < 4; ++j)
#pragma unroll
                for (int w = 0; w < 3; ++w) sum += uu[j][w].x ^ uu[j][w].y ^ uu[j][w].z ^ uu[j][w].w ^ vv[j][w].x ^ vv[j][w].y ^ vv[j][w].z ^ vv[j][w].w;
        }
#endif
        if (sum == 0x12345677u) XA[(size_t)r * 1024 + lane] = 0.f;
    }
}
#endif
DEVI void ph_peer_select(const Params& p, int layer, float* smem) {
    const bf16* QP = (const bf16*)(p.ws + WS_QP); const bf16* SKB = (const bf16*)(p.ws + WT_SK) + (size_t)layer * 16 * 128 * 128;
    int* EID = (int*)(p.ws + WS_EID); float* GATE = (float*)(p.ws + WS_GATE);
    const int tid = tidx(), wid = tid >> 6, lane = tid & 63, fr = lane & 15, fq = lane >> 4;
    const int nblk = layer == DEPTH - 1 ? TX / 128 : T / 128;
    constexpr int LS = 129;
    float* SCL = smem;
    for (int it = blockIdx.x; it < nblk * 8; it += gridDim.x) {
        const int tb = it >> 3, h = it & 7, r0 = tb * 128;
        {
            const int pp = wid & 1, tg = wid >> 1;
            const bf16* Aq = SKB + ((size_t)(h * 2 + pp) * 128) * 128; const bf16* Bq = QP + (size_t)(r0 + tg * 32) * 2048 + h * 256 + pp * 128;
            f32x4 acc[8][2];
#pragma unroll
            for (int a = 0; a < 8; ++a) { acc[a][0] = (f32x4){0.f, 0.f, 0.f, 0.f}; acc[a][1] = (f32x4){0.f, 0.f, 0.f, 0.f}; }
#pragma unroll
            for (int ks = 0; ks < 4; ++ks) {
                bf16x8 bfr[2], afr[8];
#pragma unroll
                for (int n = 0; n < 2; ++n) bfr[n] = *(const bf16x8*)(Bq + (size_t)(n * 16 + fr) * 2048 + ks * 32 + fq * 8);
#pragma unroll
                for (int m = 0; m < 8; ++m) afr[m] = *(const bf16x8*)(Aq + (size_t)(m * 16 + fr) * 128 + ks * 32 + fq * 8);
#pragma unroll
                for (int m = 0; m < 8; ++m)
#pragma unroll
                    for (int n = 0; n < 2; ++n) acc[m][n] = __builtin_amdgcn_mfma_f32_16x16x32_bf16(afr[m], bfr[n], acc[m][n], 0, 0, 0);
            }
            __syncthreads();
#pragma unroll
            for (int m = 0; m < 8; ++m)
#pragma unroll
                for (int n = 0; n < 2; ++n) { float* d = SCL + (size_t)(pp * 128 + tg * 32 + n * 16 + fr) * LS + m * 16 + fq * 4;
                    d[0] = acc[m][n].x; d[1] = acc[m][n].y; d[2] = acc[m][n].z; d[3] = acc[m][n].w; }
        }
        __syncthreads();
        const int tok = tid & 127, pp = (tid >> 7) & 1, kh = tid >> 8;
        float K1[16];
#pragma unroll
        for (int j = 0; j < 16; ++j) K1[j] = -3.0e38f;
        { const float* sp = SCL + (size_t)(pp * 128 + tok) * LS + kh * 64;
#pragma unroll 8
          for (int k = 0; k < 64; ++k) { const float a = sp[k]; const int id = kh * 64 + k; const float key = __uint_as_float((__float_as_uint(a) & ~127u) | (unsigned)(a >= 0.f ? 127 - id : id)); KEY_INSERT(K1, key); } }
        __syncthreads();
        float* XV = smem;
        if (kh == 1) {
#pragma unroll
            for (int j = 0; j < 16; ++j) XV[(pp * 128 + tok) * 17 + j] = K1[j]; }
        __syncthreads();
        if (kh == 0) {
#pragma unroll 4
            for (int j = 0; j < 16; ++j) { const float key = XV[(pp * 128 + tok) * 17 + j]; KEY_INSERT(K1, key); } }
        __syncthreads();
        if (kh == 0 && pp == 1) {
#pragma unroll
            for (int j = 0; j < 16; ++j) XV[tok * 17 + j] = K1[j]; }
        __syncthreads();
        if (kh == 0 && pp == 0) {
            float K2[16];
#pragma unroll
            for (int j = 0; j < 16; ++j) K2[j] = XV[tok * 17 + j];
            int* XI = (int*)smem + 256 * 17 + tok * 33;
#pragma unroll
            for (int j = 0; j < 16; ++j) { const unsigned b1 = __float_as_uint(K1[j]) & 127u, b2 = __float_as_uint(K2[j]) & 127u; XI[j] = K1[j] >= 0.f ? 127 - (int)b1 : (int)b1; XI[16 + j] = K2[j] >= 0.f ? 127 - (int)b2 : (int)b2; }
            float B[16];
#pragma unroll
            for (int j = 0; j < 16; ++j) B[j] = -3.0e38f;
#pragma unroll
            for (int i = 0; i < 16; ++i)
#pragma unroll
                for (int j = 0; j < 16; ++j) if ((i + 1) * (j + 1) <= 16) { const float sc = K1[i] + K2[j]; const int f = i * 16 + j;
                    const float key = __uint_as_float((__float_as_uint(sc) & ~255u) | (unsigned)(sc >= 0.f ? 255 - f : f)); KEY_INSERT(B, key); }
            float e[16], sum = 0.f; int id[16];
#pragma unroll
            for (int j = 0; j < 16; ++j) { e[j] = __expf(B[j] - B[0]); sum += e[j]; const unsigned bb = __float_as_uint(B[j]) & 255u; const int f = B[j] >= 0.f ? 255 - (int)bb : (int)bb; id[j] = XI[f >> 4] * 128 + XI[16 + (f & 15)]; }
            const float inv = 1.f / sum; const size_t o = ((size_t)(r0 + tok) * 8 + h) * 16;
#pragma unroll
            for (int j = 0; j < 16; j += 4) { *(u32x4*)(EID + o + j) = (u32x4){(unsigned)id[j], (unsigned)id[j + 1], (unsigned)id[j + 2], (unsigned)id[j + 3]};
                *(f32x4*)(GATE + o + j) = (f32x4){e[j] * inv, e[j + 1] * inv, e[j + 2] * inv, e[j + 3] * inv}; }
        }
    }
}
DEVI void ph_subkeys(const Params& p) {
    const f32x4* S = (const f32x4*)p.peer_sub_keys; u32x2* O = (u32x2*)(p.ws + WT_SK);
    for (int i = blockIdx.x * NTHR + tidx(); i < 4 * 16 * 128 * 128 / 4; i += gridDim.x * NTHR) { const f32x4 a = S[i]; u32x2 o; o.x = pk2(a.x, a.y); o.y = pk2(a.z, a.w); O[i] = o; }
}

constexpr int SLD = 144;
DEVI s16x4 trr(int addr) { s16x4 r; asm volatile("ds_read_b64_tr_b16 %0, %1" : "=&v"(r) : "v"(addr) : "memory"); return r; }
#define LGKM0() do { asm volatile("s_waitcnt lgkmcnt(0)" ::: "memory"); SBAR(); } while (0)
DEVI bf16x8 pk8(const s16x4 l, const s16x4 h) { return (bf16x8){l[0], l[1], l[2], l[3], h[0], h[1], h[2], h[3]}; }
DEVI bf16x8 cvt8(const f32x4 a, const f32x4 b) { u32x4 w = {pk2(a.x, a.y), pk2(a.z, a.w), pk2(b.x, b.y), pk2(b.z, b.w)}; return *reinterpret_cast<bf16x8*>(&w); }
#define SCAN_DECODE(it_, n_, dir_, hh_, b_) const int n_ = (it_) % NCHUNK, sc_ = (it_) / NCHUNK, dir_ = sc_ & 1, hh_ = (sc_ >> 1) & 7, b_ = sc_ >> 4
DEVI void ph_scan1(const Params& p, int layer, unsigned char* lds) {
    const int jl = layer >> 1, tid = tidx(), wid = tid >> 6, lane = tid & 63, fr = lane & 15, fq = lane >> 4, k = tid & 127, I = tid >> 7;
    const float* LF = (const float*)(p.ws + WS_LF); const bf16 *VS = (const bf16*)(p.ws + WS_VS), *KR = (const bf16*)(p.ws + WS_KR);
    bf16* UT = (bf16*)(p.ws + WS_UT); float* DEC = (float*)(p.ws + WS_DEC);
    bf16* KH = (bf16*)lds; bf16* VV = KH + 64 * SLD; float* TOT = (float*)(VV + 64 * SLD);
    const int trb = (int)(uintptr_t)lds + (((lane >> 2) & 3) * SLD + (lane & 3) * 4) * 2;
    const int NIT = 32 * NCHUNK, G = gridDim.x;
    float rlf[16]; unsigned short rkr[16], rvs[16];
#define S1_LOAD(itx) do { SCAN_DECODE(itx, n2, dir2, hh2, b2); \
        if (hh2 < 4) { _Pragma("unroll") for (int i = 0; i < 16; ++i) rlf[i] = LF[((size_t)dir2 * T + scan_row(b2, dir2, n2 * 64 + I * 16 + i)) * 512 + hh2 * 128 + k]; } \
        else { _Pragma("unroll") for (int i = 0; i < 16; ++i) rkr[i] = KR[(size_t)scan_row(b2, dir2, n2 * 64 + I * 16 + i) * 512 + (hh2 - 4) * 128 + k]; } \
        _Pragma("unroll") for (int i = 0; i < 16; ++i) rvs[i] = VS[(size_t)scan_row(b2, dir2, n2 * 64 + I * 16 + i) * 1024 + hh2 * 128 + k]; } while (0)
    if ((int)blockIdx.x < NIT) S1_LOAD((int)blockIdx.x);
    for (int it = blockIdx.x; it < NIT; it += G) {
        SCAN_DECODE(it, n, dir, hh, b); (void)n; (void)b;
        const float lg = hh >= 4 ? -__expf(p.ret_log_decay[(jl * 2 + dir) * 4 + (hh - 4)]) : 0.f;
        float lc[16], kk[16]; float run = 0.f;
#pragma unroll
        for (int i = 0; i < 16; ++i) { const float lf = hh < 4 ? rlf[i] : lg; const float kv = hh < 4 ? 1.f - __expf(lf) : bf2f(rkr[i]); run += lf; lc[i] = run; kk[i] = kv; }
        TOT[I * 128 + k] = run;
        __syncthreads();
        float after = 0.f;
#pragma unroll
        for (int J = 0; J < 4; ++J) after += (J > I) ? TOT[J * 128 + k] : 0.f;
        if (I == 0) DEC[(size_t)it * 128 + k] = __expf(after + run);
        { const float ea = __expf(after + run);
#pragma unroll
          for (int i = 0; i < 16; ++i) { KH[(I * 16 + i) * SLD + k] = f2bf_hw(kk[i] * __expf(-lc[i]) * ea); VV[(I * 16 + i) * SLD + k] = rvs[i]; } }
        if (it + G < NIT) S1_LOAD(it + G);
        __syncthreads();
        f32x4 acc[8];
#pragma unroll
        for (int a = 0; a < 8; ++a) acc[a] = (f32x4){0.f, 0.f, 0.f, 0.f};
#pragma unroll
        for (int t = 0; t < 2; ++t) {
            const int rb = trb + ((32 * t + 8 * fq) * SLD) * 2;
            const s16x4 al = trr(rb + (16 * wid) * 2), ah = trr(rb + (4 * SLD + 16 * wid) * 2);
            s16x4 bl[8], bh[8];
#pragma unroll
            for (int nt = 0; nt < 8; ++nt) { bl[nt] = trr(rb + (64 * SLD + 16 * nt) * 2); bh[nt] = trr(rb + (68 * SLD + 16 * nt) * 2); }
            LGKM0();
            const bf16x8 A = pk8(al, ah);
#pragma unroll
            for (int nt = 0; nt < 8; ++nt) acc[nt] = __builtin_amdgcn_mfma_f32_16x16x32_bf16(A, pk8(bl[nt], bh[nt]), acc[nt], 0, 0, 0);
        }
        bf16* U = UT + (size_t)it * 16384 + 16 * wid + fq * 4;
#pragma unroll
        for (int nt = 0; nt < 8; ++nt) *(u32x2*)(U + (size_t)(nt * 16 + fr) * 128) = pk4(acc[nt]);
    }
#undef S1_LOAD
}
DEVI void ph_scan2(const Params& p) {
    u32x4* UT = (u32x4*)(p.ws + WS_UT); const float* DEC = (const float*)(p.ws + WS_DEC); const int tid = tidx();
    for (int it = blockIdx.x; it < 32 * 4; it += gridDim.x) {
        const int sc = it >> 2, e8 = (it & 3) * NTHR + tid, k8 = (e8 & 15) * 8; float st[8];
#pragma unroll
        for (int i = 0; i < 8; ++i) st[i] = 0.f;
        u32x4* u = UT + (size_t)sc * NCHUNK * 2048 + e8; const float* dp = DEC + (size_t)sc * NCHUNK * 128 + k8;
        for (int n0 = 0; n0 < NCHUNK; n0 += 6) {
            u32x4 uu[6]; f32x4 d0[6], d1[6];
#pragma unroll
            for (int j = 0; j < 6; ++j) { uu[j] = u[(size_t)(n0 + j) * 2048]; d0[j] = *(const f32x4*)(dp + (size_t)(n0 + j) * 128); d1[j] = *(const f32x4*)(dp + (size_t)(n0 + j) * 128 + 4); }
#pragma unroll
            for (int j = 0; j < 6; ++j) {
                u32x4 o; o.x = pk2(st[0], st[1]); o.y = pk2(st[2], st[3]); o.z = pk2(st[4], st[5]); o.w = pk2(st[6], st[7]); u[(size_t)(n0 + j) * 2048] = o;
                st[0] = d0[j].x * st[0] + bflo(uu[j].x); st[1] = d0[j].y * st[1] + bfhi(uu[j].x); st[2] = d0[j].z * st[2] + bflo(uu[j].y); st[3] = d0[j].w * st[3] + bfhi(uu[j].y);
                st[4] = d1[j].x * st[4] + bflo(uu[j].z); st[5] = d1[j].y * st[5] + bfhi(uu[j].z); st[6] = d1[j].z * st[6] + bflo(uu[j].w); st[7] = d1[j].w * st[7] + bfhi(uu[j].w);
            }
        }
    }
}
DEVI void ph_scan3(const Params& p, int layer, unsigned char* lds) {
    const int jl = layer >> 1, tid = tidx(), wid = tid >> 6, lane = tid & 63, fr = lane & 15, fq = lane >> 4, k = tid & 127, I = tid >> 7;
    const float* LF = (const float*)(p.ws + WS_LF); const bf16 *VS = (const bf16*)(p.ws + WS_VS), *KR = (const bf16*)(p.ws + WS_KR), *QS = (const bf16*)(p.ws + WS_QS);
    const bf16* UT = (const bf16*)(p.ws + WS_UT); bf16* OFB = (bf16*)(p.ws + WS_OFB);
    bf16* QH = (bf16*)lds; bf16* QT = QH + 64 * SLD; bf16* VV = QT + 64 * SLD; bf16* KT = VV + 64 * SLD; float* TOT = (float*)(KT + 160 * SLD);
    const int trv = (int)(uintptr_t)VV + (((lane >> 2) & 3) * SLD + (lane & 3) * 4 + 16 * wid) * 2 + (4 * fq * SLD) * 2;
    const int NIT = 32 * NCHUNK, G = gridDim.x;
    float rlf[16]; unsigned short rkr[16], rvs[16], rqs[16];
#define S3_LOAD(itx) do { SCAN_DECODE(itx, n2, dir2, hh2, b2); \
        if (hh2 < 4) { _Pragma("unroll") for (int i = 0; i < 16; ++i) rlf[i] = LF[((size_t)dir2 * T + scan_row(b2, dir2, n2 * 64 + I * 16 + i)) * 512 + hh2 * 128 + k]; } \
        else { _Pragma("unroll") for (int i = 0; i < 16; ++i) rkr[i] = KR[(size_t)scan_row(b2, dir2, n2 * 64 + I * 16 + i) * 512 + (hh2 - 4) * 128 + k]; } \
        _Pragma("unroll") for (int i = 0; i < 16; ++i) { const int row = scan_row(b2, dir2, n2 * 64 + I * 16 + i); rvs[i] = VS[(size_t)row * 1024 + hh2 * 128 + k]; rqs[i] = QS[(size_t)row * 1024 + hh2 * 128 + k]; } } while (0)
    if ((int)blockIdx.x < NIT) S3_LOAD((int)blockIdx.x);
    for (int it = blockIdx.x; it < NIT; it += G) {
        SCAN_DECODE(it, n, dir, hh, b);
        const float lg = hh >= 4 ? -__expf(p.ret_log_decay[(jl * 2 + dir) * 4 + (hh - 4)]) : 0.f;
        bf16x8 stv[4];
        { const bf16* ST = UT + (size_t)it * 16384 + (size_t)(16 * wid + fr) * 128 + fq * 8;
#pragma unroll
          for (int ks = 0; ks < 4; ++ks) stv[ks] = *(const bf16x8*)(ST + ks * 32); }
        float lc[16], kk[16]; float run = 0.f;
#pragma unroll
        for (int i = 0; i < 16; ++i) { const float lf = hh < 4 ? rlf[i] : lg; const float kv = hh < 4 ? 1.f - __expf(lf) : bf2f(rkr[i]); run += lf; lc[i] = run; kk[i] = kv; }
        TOT[I * 128 + k] = run;
        __syncthreads();
        float ref = 0.f;
#pragma unroll
        for (int J = 0; J < 4; ++J) ref += (J < I) ? TOT[J * 128 + k] : 0.f;
        { const float er = __expf(ref);
#pragma unroll
          for (int i = 0; i < 16; ++i) { const int c = I * 16 + i; const float e = __expf(lc[i]), qt = bf2f(rqs[i]) * e;
              QH[c * SLD + k] = f2bf_hw(qt * er); QT[c * SLD + k] = f2bf_hw(qt); VV[c * SLD + k] = rvs[i]; kk[i] *= __builtin_amdgcn_rcpf(e); } }
        { float delta = 0.f;
#pragma unroll
          for (int I2 = 0; I2 < 4; ++I2) { if (I2 >= I) { bf16* kt = KT + ((I2 * (I2 + 1) / 2 + I) * 16) * SLD + k; const float ed = __expf(delta);
#pragma unroll
                  for (int i = 0; i < 16; ++i) kt[i * SLD] = f2bf_hw(kk[i] * ed);
                  delta += TOT[I2 * 128 + k]; } } }
        if (it + G < NIT) S3_LOAD(it + G);
        __syncthreads();
        f32x4 acc[4];
#pragma unroll
        for (int a = 0; a < 4; ++a) acc[a] = (f32x4){0.f, 0.f, 0.f, 0.f};
#pragma unroll
        for (int ks = 0; ks < 4; ++ks) { const bf16x8 A = stv[ks];
#pragma unroll
            for (int c4 = 0; c4 < 4; ++c4) acc[c4] = __builtin_amdgcn_mfma_f32_16x16x32_bf16(A, *(const bf16x8*)(QH + (c4 * 16 + fr) * SLD + ks * 32 + fq * 8), acc[c4], 0, 0, 0); }
#pragma unroll
        for (int I2 = 0; I2 < 4; ++I2) {
            f32x4 at[4];
#pragma unroll
            for (int J = 0; J < 4; ++J) { at[J] = (f32x4){0.f, 0.f, 0.f, 0.f};
                if (J <= I2) {
#pragma unroll
                    for (int ks = 0; ks < 4; ++ks) at[J] = __builtin_amdgcn_mfma_f32_16x16x32_bf16(*(const bf16x8*)(KT + ((I2 * (I2 + 1) / 2 + J) * 16 + fr) * SLD + ks * 32 + fq * 8),
                                                                                                   *(const bf16x8*)(QT + (I2 * 16 + fr) * SLD + ks * 32 + fq * 8), at[J], 0, 0, 0);
                    if (J == I2) { if (fq * 4 + 0 > fr) at[J].x = 0.f; if (fq * 4 + 1 > fr) at[J].y = 0.f; if (fq * 4 + 2 > fr) at[J].z = 0.f; if (fq * 4 + 3 > fr) at[J].w = 0.f; }
                } }
#pragma unroll
            for (int t = 0; t < 2; ++t) if (2 * t <= I2) {
                const s16x4 vl = trr(trv + ((2 * t) * 16 * SLD) * 2), vh = trr(trv + ((2 * t + 1) * 16 * SLD) * 2);
                LGKM0();
                acc[I2] = __builtin_amdgcn_mfma_f32_16x16x32_bf16(pk8(vl, vh), cvt8(at[2 * t], at[2 * t + 1]), acc[I2], 0, 0, 0);
            }
        }
#pragma unroll
        for (int c4 = 0; c4 < 4; ++c4) { const int row = scan_row(b, dir, n * 64 + c4 * 16 + fr);
            *(u32x2*)(OFB + ((size_t)dir * T + row) * 1024 + hh * 128 + 16 * wid + fq * 4) = pk4(acc[c4]); }
    }
#undef S3_LOAD
}

constexpr size_t WT_GW = WS_WT + 54 * MiB;
DEVI void ph_gmlp(const Params& p, int layer, unsigned char* lds) {
    const int j = layer >> 1, tid = tidx(), wid = tid >> 6, lane = tid & 63, fr = lane & 15, fq = lane >> 4;
    const bf16 *UB = (const bf16*)(p.ws + WS_UB), *VG = (const bf16*)(p.ws + WS_VG); bf16* OX = (bf16*)(p.ws + WS_OX);
    bf16* VN = (bf16*)lds;
    const int trb = (int)(uintptr_t)lds + (((lane >> 2) & 3) * SLD + (lane & 3) * 4 + 16 * wid) * 2 + (8 * fq * SLD) * 2;
    const int nfull = ((T / 128) * 4 / (int)gridDim.x) * (int)gridDim.x;
    for (int k = 0;; ++k) {
        int it = k * (int)gridDim.x + (int)blockIdx.x;
        if (it >= nfull) { const int rem = (int)blockIdx.x - 16; if (k * (int)gridDim.x != nfull || rem < 0 || nfull + rem >= (T / 128) * 4) break; it = nfull + rem; }
        const int ch = it >> 2, g = it & 3, r0 = ch * 128;
        __syncthreads();
#pragma unroll 4
        for (int rr = 0; rr < 16; ++rr) {
            const int row = wid * 16 + rr; const u32x4 a = *(const u32x4*)(VG + (size_t)(r0 + row) * 512 + lane * 8);
            float x[8] = {bflo(a.x), bfhi(a.x), bflo(a.y), bfhi(a.y), bflo(a.z), bfhi(a.z), bflo(a.w), bfhi(a.w)};
            float sm = 0.f;
#pragma unroll
            for (int i = 0; i < 8; ++i) sm += x[i];
            const float mean = wave_sum(sm) * (1.f / 512.f); float qq = 0.f;
#pragma unroll
            for (int i = 0; i < 8; ++i) { x[i] -= mean; qq += x[i] * x[i]; }
            const float rstd = rsqrtf(wave_sum(qq) * (1.f / 512.f) + EPS);
            if ((lane >> 4) == g) { const float* gn = p.gmlp_v_gain + j * 512 + lane * 8; const f32x4 g0 = *(const f32x4*)gn, g1 = *(const f32x4*)(gn + 4);
                u32x4 o; o.x = pk2(x[0] * rstd * g0.x, x[1] * rstd * g0.y); o.y = pk2(x[2] * rstd * g0.z, x[3] * rstd * g0.w); o.z = pk2(x[4] * rstd * g1.x, x[5] * rstd * g1.y); o.w = pk2(x[6] * rstd * g1.z, x[7] * rstd * g1.w);
                *(u32x4*)(VN + row * SLD + (lane & 15) * 8) = o; }
        }
        __syncthreads();
        const bf16* WB = (const bf16*)(p.ws + WT_GW) + (size_t)(j * 4 + g) * 128 * 128;
        f32x4 acc[8];
#pragma unroll
        for (int a = 0; a < 8; ++a) acc[a] = (f32x4){0.f, 0.f, 0.f, 0.f};
#pragma unroll
        for (int ks = 0; ks < 4; ++ks) {
            bf16x8 bw[8];
#pragma unroll
            for (int nt = 0; nt < 8; ++nt) bw[nt] = *(const bf16x8*)(WB + (size_t)(nt * 16 + fr) * 128 + ks * 32 + fq * 8);
            const s16x4 al = trr(trb + (32 * ks * SLD) * 2), ah = trr(trb + ((32 * ks + 4) * SLD) * 2);
            LGKM0();
            const bf16x8 A = pk8(al, ah);
#pragma unroll
            for (int nt = 0; nt < 8; ++nt) acc[nt] = __builtin_amdgcn_mfma_f32_16x16x32_bf16(A, bw[nt], acc[nt], 0, 0, 0);
        }
#pragma unroll
        for (int nt = 0; nt < 8; ++nt) { const int pi = nt * 16 + fr; const float bsv = p.gmlp_bs[(j * 4 + g) * 128 + pi];
            const size_t o = (size_t)(r0 + pi) * 1024 + g * 128 + 16 * wid + fq * 4; const u32x2 uu = *(const u32x2*)(UB + (size_t)(r0 + pi) * 512 + g * 128 + 16 * wid + fq * 4);
            u32x2 w; w.x = pk2(bflo(uu.x) * (acc[nt].x + bsv), bfhi(uu.x) * (acc[nt].y + bsv)); w.y = pk2(bflo(uu.y) * (acc[nt].z + bsv), bfhi(uu.y) * (acc[nt].w + bsv));
            *(u32x2*)(OX + o) = w; }
    }
}
DEVI void ph_gmlp_weights(const Params& p) {
    const f32x4* S = (const f32x4*)p.gmlp_ws; u32x2* O = (u32x2*)(p.ws + WT_GW);
    for (int i = blockIdx.x * NTHR + tidx(); i < 2 * 4 * 128 * 128 / 4; i += gridDim.x * NTHR) { const f32x4 a = S[i]; u32x2 o; o.x = pk2(a.x, a.y); o.y = pk2(a.z, a.w); O[i] = o; }
}

namespace pg8 {
#define PG8_LAS __attribute__((address_space(3)))
typedef unsigned short bf16_t;
typedef short bf16x8 __attribute__((ext_vector_type(8)));
typedef float f32x4 __attribute__((ext_vector_type(4)));
typedef unsigned u32x4 __attribute__((ext_vector_type(4)));
constexpr int BM = 256, BK = 64, HALF = 128, HTB = HALF * BK * 2  , STAGE_BYTES = 8 * HTB, NXCD = 8, WGM = 8;

__host__ __device__ __forceinline__ int lds_byte(int r, int c) { const int st = (r >> 4) * 2 + (c >> 5), rr = r & 15, cc = c & 31, ob = rr * 64 + cc * 2; return st * 1024 + (ob ^ (((ob >> 9) & 1) << 5)); }
__host__ __device__ __forceinline__ void stage_rc(int b, int& R, int& C) { const int st = b / 1024, sb = b % 1024, swz = sb ^ (((sb >> 9) & 1) << 5); R = (st >> 1) * 16 + swz / 64; C = (st & 1) * 32 + (swz % 64) / 2; }
__host__ __device__ __forceinline__ int perm32(int rho) { const int n = rho >> 4, i = rho & 15; return 8 * (i >> 2) + 4 * n + (i & 3); }

struct Unit { int pm, pn; };
struct Gemm { const bf16_t* A; const bf16_t* Bt; int M, N, K; };

struct StaticOrder {
    int nM, nN, nwg, G, c;
    __host__ __device__ void init(int M, int N, int G_, int c_) { nM = M / BM; nN = N / BM; nwg = nM * nN; G = G_; c = c_; }
    __host__ __device__ bool next(int i, Unit& u) const {
        const long L = (long)i * G + c; if (L >= nwg) return false;
        int wgid = (int)L; { const int q = nwg / NXCD, r = nwg % NXCD, xcd = wgid % NXCD, off = wgid / NXCD; wgid = (xcd < r ? xcd * (q + 1) : r * (q + 1) + (xcd - r) * q) + off; }
        const int nig = WGM * nN, gid = wgid / nig, fm = gid * WGM, gsz = (nM - fm) < WGM ? (nM - fm) : WGM;
        u.pm = fm + ((wgid % nig) % gsz); u.pn = (wgid % nig) / gsz; return true;
    }
    __device__ __forceinline__ void a_ready(const Unit&) const {}
    __device__ __forceinline__ void done(const Unit&) const {}
};

template <class Epi, class Sched, bool ALIGN_EPI = false, bool SP2 = false>
__device__ __forceinline__ void gemm_phase(PG8_LAS unsigned char* lds, const Gemm g, const Sched& S, const Epi& E) {
    const int tid = tidx(), wid = __builtin_amdgcn_readfirstlane(tid >> 6), lane = tid & 63, wr = wid >> 2, wc = wid & 3, fr = lane & 15, fq = lane >> 4;
    const int K = g.K, nt = K / BK;
    unsigned voffA[2], voffB[2];
#pragma unroll
    for (int i = 0; i < 2; ++i) { int R, C; stage_rc(tid * 16 + i * 8192, R, C); const int Rb = Epi::PERM ? ((R & ~31) + perm32(R & 31)) : R;
        voffA[i] = (unsigned)(R * K + C) * 2u; voffB[i] = (unsigned)(Rb * K + C) * 2u; }
    const size_t kstep = (size_t)(BK * 2);
    const size_t hstep = (size_t)HALF * K * 2;
    const size_t tstep = 2 * hstep;
    const unsigned ldsw = (unsigned)wid * 1024u;
    const int aoff = lds_byte(wr * 64 + fr, fq * 8), boff = lds_byte(wc * 32 + fr, fq * 8);
#define PG8_SA(b, h) (((b) * 2 + (h)) * HTB)
#define PG8_SB(b, h) ((4 + (b) * 2 + (h)) * HTB)
#define PG8_STAGE(bufoff, gbase, voff) do { _Pragma("unroll") for (int _i = 0; _i < 2; ++_i) \
        __builtin_amdgcn_global_load_lds((const unsigned*)((const char*)(gbase) + (voff)[_i]), (PG8_LAS unsigned*)(lds + (bufoff) + ldsw + _i * 8192), 16, 0, 0); } while (0)
#define PG8_LDA(dst, b, h) do { _Pragma("unroll") for (int m = 0; m < 4; ++m) _Pragma("unroll") for (int k = 0; k < 2; ++k) dst[m][k] = *(const PG8_LAS bf16x8*)(lds + PG8_SA(b, h) + aoff + m * 2048 + k * 1024); } while (0)
#define PG8_LDB(dst, b, h) do { _Pragma("unroll") for (int n = 0; n < 2; ++n) _Pragma("unroll") for (int k = 0; k < 2; ++k) dst[n][k] = *(const PG8_LAS bf16x8*)(lds + PG8_SB(b, h) + boff + n * 2048 + k * 1024); } while (0)
#define PG8_MMA(ai, bj, At, Bt) do { __builtin_amdgcn_s_setprio(1); _Pragma("unroll") for (int m = 0; m < 4; ++m) _Pragma("unroll") for (int n = 0; n < 2; ++n) _Pragma("unroll") for (int k = 0; k < 2; ++k) \
        acc[ai][bj][m][n] = __builtin_amdgcn_mfma_f32_16x16x32_bf16(Bt[n][k], At[m][k], acc[ai][bj][m][n], 0, 0, 0); __builtin_amdgcn_s_setprio(0); } while (0)
#define PG8_WAIT_V(n) asm volatile("s_waitcnt vmcnt(" #n ")" ::: "memory")
#define PG8_WAIT_L(n) asm volatile("s_waitcnt lgkmcnt(" #n ")" ::: "memory")
#define PG8_BAR __builtin_amdgcn_s_barrier()
#define PG8_SCHED __builtin_amdgcn_sched_barrier(0)
    Unit cur, nxt; int ui = 0;
    if (!S.next(0, cur)) return;
    f32x4 acc[2][2][4][2];
#pragma unroll
    for (int a = 0; a < 2; ++a)
#pragma unroll
        for (int b = 0; b < 2; ++b)
#pragma unroll
            for (int m = 0; m < 4; ++m)
#pragma unroll
                for (int n = 0; n < 2; ++n) acc[a][b][m][n] = (f32x4){0.f, 0.f, 0.f, 0.f};
    bf16x8 At[4][2], B0[2][2], B1[2][2];
    const char* cA = (const char*)g.A + (size_t)cur.pm * tstep; const char* cB = (const char*)g.Bt + (size_t)cur.pn * tstep;
    S.a_ready(cur);
    if constexpr (SP2) {
        PG8_STAGE(PG8_SB(0, 0), cB, voffB); PG8_STAGE(PG8_SB(0, 1), cB + hstep, voffB); PG8_STAGE(PG8_SA(0, 0), cA, voffA); PG8_STAGE(PG8_SA(0, 1), cA + hstep, voffA);
        if (wr == 1) PG8_BAR;
        PG8_WAIT_V(2); PG8_BAR;
        PG8_STAGE(PG8_SB(1, 0), cB + kstep, voffB); PG8_STAGE(PG8_SA(1, 0), cA + kstep, voffA); PG8_STAGE(PG8_SB(1, 1), cB + hstep + kstep, voffB);
        PG8_WAIT_V(6); PG8_BAR;
    } else {
        PG8_STAGE(PG8_SB(0, 0), cB, voffB); PG8_STAGE(PG8_SA(0, 0), cA, voffA); PG8_STAGE(PG8_SB(0, 1), cB + hstep, voffB); PG8_STAGE(PG8_SA(0, 1), cA + hstep, voffA);
        if (wr == 1) PG8_BAR;
        PG8_WAIT_V(4); PG8_BAR;
        PG8_STAGE(PG8_SB(1, 0), cB + kstep, voffB); PG8_STAGE(PG8_SA(1, 0), cA + kstep, voffA); PG8_STAGE(PG8_SB(1, 1), cB + hstep + kstep, voffB);
        PG8_WAIT_V(6); PG8_BAR;
    }
    for (;;) {
        const bool has_next = S.next(ui + 1, nxt);
        const char* nA = has_next ? (const char*)g.A + (size_t)nxt.pm * tstep : cA; const char* nB = has_next ? (const char*)g.Bt + (size_t)nxt.pn * tstep : cB;
        for (int t = 0; t < nt; t += 2) {
            const bool last = (t == nt - 2);
            const char* a1 = cA + (size_t)(t + 1) * kstep;
            const char* a2 = last ? nA : cA + (size_t)(t + 2) * kstep; const char* b2 = last ? nB : cB + (size_t)(t + 2) * kstep;
            const char* a3 = a2 + kstep; const char* b3 = b2 + kstep;
            if (last && has_next) S.a_ready(nxt);
            if constexpr (SP2) {
            PG8_LDB(B0, 0, 0); PG8_LDB(B1, 0, 1); PG8_SCHED; PG8_LDA(At, 0, 0); PG8_STAGE(PG8_SA(1, 1), a1 + hstep, voffA);
            PG8_WAIT_V(8); PG8_WAIT_L(0); PG8_BAR; PG8_MMA(0, 0, At, B0); PG8_MMA(0, 1, At, B1); PG8_BAR; PG8_SCHED;
            PG8_LDA(At, 0, 1); PG8_STAGE(PG8_SB(0, 0), b2, voffB); PG8_STAGE(PG8_SB(0, 1), b2 + hstep, voffB); PG8_STAGE(PG8_SA(0, 0), a2, voffA);
            PG8_WAIT_V(8); PG8_WAIT_L(0); PG8_BAR; PG8_MMA(1, 0, At, B0); PG8_MMA(1, 1, At, B1); PG8_BAR; PG8_SCHED;
            PG8_LDB(B0, 1, 0); PG8_LDB(B1, 1, 1); PG8_SCHED; PG8_LDA(At, 1, 0); PG8_STAGE(PG8_SA(0, 1), a2 + hstep, voffA);
            PG8_WAIT_V(8); PG8_WAIT_L(0); PG8_BAR; PG8_MMA(0, 0, At, B0); PG8_MMA(0, 1, At, B1); PG8_BAR; PG8_SCHED;
            PG8_LDA(At, 1, 1); PG8_STAGE(PG8_SB(1, 0), b3, voffB); PG8_STAGE(PG8_SB(1, 1), b3 + hstep, voffB); PG8_STAGE(PG8_SA(1, 0), a3, voffA);
            PG8_WAIT_V(8); PG8_WAIT_L(0); PG8_BAR; PG8_MMA(1, 0, At, B0); PG8_MMA(1, 1, At, B1); PG8_BAR; PG8_SCHED;
            } else {
            PG8_LDB(B0, 0, 0); PG8_SCHED; PG8_LDA(At, 0, 0); PG8_STAGE(PG8_SA(1, 1), a1 + hstep, voffA);
            PG8_WAIT_L(8); PG8_BAR; PG8_WAIT_L(0); PG8_MMA(0, 0, At, B0); PG8_BAR; PG8_SCHED;
            PG8_LDB(B1, 0, 1); PG8_STAGE(PG8_SB(0, 0), b2, voffB);
            PG8_BAR; PG8_WAIT_L(0); PG8_MMA(0, 1, At, B1); PG8_BAR;
            PG8_LDA(At, 0, 1); PG8_STAGE(PG8_SA(0, 0), a2, voffA);
            PG8_BAR; PG8_WAIT_L(0); PG8_MMA(1, 0, At, B0); PG8_BAR; PG8_SCHED;
            PG8_STAGE(PG8_SB(0, 1), b2 + hstep, voffB);
            PG8_WAIT_V(6); PG8_BAR; PG8_MMA(1, 1, At, B1); PG8_BAR;
            PG8_LDB(B0, 1, 0); PG8_SCHED; PG8_LDA(At, 1, 0); PG8_STAGE(PG8_SA(0, 1), a2 + hstep, voffA);
            PG8_WAIT_L(8); PG8_BAR; PG8_WAIT_L(0); PG8_MMA(0, 0, At, B0); PG8_BAR; PG8_SCHED;
            PG8_LDB(B1, 1, 1); PG8_STAGE(PG8_SB(1, 0), b3, voffB);
            PG8_BAR; PG8_WAIT_L(0); PG8_MMA(0, 1, At, B1); PG8_BAR;
            PG8_LDA(At, 1, 1); PG8_STAGE(PG8_SA(1, 0), a3, voffA);
            PG8_BAR; PG8_WAIT_L(0); PG8_MMA(1, 0, At, B0); PG8_BAR; PG8_SCHED;
            PG8_STAGE(PG8_SB(1, 1), b3 + hstep, voffB);
            PG8_WAIT_V(6); PG8_BAR; PG8_MMA(1, 1, At, B1); PG8_BAR;
            }
        }
        if constexpr (ALIGN_EPI) { if (wr == 0) PG8_BAR; }
        if constexpr (!Epi::AFTER_DRAIN) { E(acc, cur, wr, wc, fr, fq); S.done(cur); }
        if (!has_next) break;
#pragma unroll
        for (int a = 0; a < 2; ++a)
#pragma unroll
            for (int b = 0; b < 2; ++b)
#pragma unroll
                for (int m = 0; m < 4; ++m)
#pragma unroll
                    for (int n = 0; n < 2; ++n) acc[a][b][m][n] = (f32x4){0.f, 0.f, 0.f, 0.f};
        cur = nxt; cA = nA; cB = nB; ++ui;
        if constexpr (ALIGN_EPI) { if (wr == 1) PG8_BAR; }
    }
    PG8_WAIT_V(0);
    if constexpr (!ALIGN_EPI) { if (wr == 0) PG8_BAR; }
    PG8_BAR;
    if constexpr (Epi::AFTER_DRAIN) { E.fused(acc, cur, wr, wc, fr, fq, lds, wid, lane); S.done(cur); }
#undef PG8_SA
#undef PG8_SB
#undef PG8_STAGE
#undef PG8_LDA
#undef PG8_LDB
#undef PG8_MMA
#undef PG8_WAIT_V
#undef PG8_WAIT_L
#undef PG8_BAR
#undef PG8_SCHED
}
}

namespace pg8 {
DEVI void rope_pair(f32x4& x1, f32x4& x2, float pos, const float (&inv)[4]) {
    const float a0 = pos * inv[0], a1 = pos * inv[1], a2 = pos * inv[2], a3 = pos * inv[3];
    const float c0 = __cosf(a0), s0 = __sinf(a0), c1 = __cosf(a1), s1 = __sinf(a1), c2 = __cosf(a2), s2 = __sinf(a2), c3 = __cosf(a3), s3 = __sinf(a3);
    const f32x4 y1 = {x1.x * c0 - x2.x * s0, x1.y * c1 - x2.y * s1, x1.z * c2 - x2.z * s2, x1.w * c3 - x2.w * s3};
    const f32x4 y2 = {x1.x * s0 + x2.x * c0, x1.y * s1 + x2.y * c1, x1.z * s2 + x2.z * c2, x1.w * s3 + x2.w * c3};
    x1 = y1; x2 = y2;
}
DEVI f32x4 gelu4(f32x4 v) { return (f32x4){gelu_(v.x), gelu_(v.y), gelu_(v.z), gelu_(v.w)}; }
DEVI f32x4 silu4(f32x4 v) { return (f32x4){silu_(v.x), silu_(v.y), silu_(v.z), silu_(v.w)}; }
struct EpiEvenP {
    static constexpr bool PERM = false, AFTER_DRAIN = false; unsigned char* ws;
    DEVI void operator()(const f32x4 (&acc)[2][2][4][2], const Unit& u, int wr, int wc, int fr, int fq) const {
        const int blk = u.pn >> 1;
        ::bf16* dst = (::bf16*)(ws + (blk == 0 ? WS_KB : blk == 1 ? WS_VB : blk == 2 ? WS_UB : blk == 3 ? WS_VG : WS_QB));
        float inv[4];
#pragma unroll
        for (int j = 0; j < 4; ++j) inv[j] = exp2f(-(float)(4 * fq + j) * (13.287712379549449f / 16.f));
#pragma unroll
        for (int bj = 0; bj < 2; ++bj) { const int cc0 = ((u.pn & 1) * 256 + 128 * bj + 32 * wc) + 4 * fq;
#pragma unroll
            for (int ai = 0; ai < 2; ++ai)
#pragma unroll
                for (int m = 0; m < 4; ++m) { const int r = u.pm * BM + 128 * ai + 64 * wr + 16 * m + fr; f32x4 x1 = acc[ai][bj][m][0], x2 = acc[ai][bj][m][1];
                    if (blk == 0 || blk == 4) { const int t = r & (SEQ - 1); rope_pair(x1, x2, (float)((wc & 1) ? (t & 63) : (t >> 6)), inv);
                        if (blk == 4) { x1 = x1 * (DIFF_SCALE * LOG2E); x2 = x2 * (DIFF_SCALE * LOG2E); } }
                    else if (blk >= 2) { x1 = gelu4(x1); x2 = gelu4(x2); }
                    *(u32x2*)(dst + (size_t)r * 512 + cc0) = pk4(x1); *(u32x2*)(dst + (size_t)r * 512 + cc0 + 16) = pk4(x2); } }
    }
};
struct EpiOddP {
    static constexpr bool PERM = false, AFTER_DRAIN = false; unsigned char* ws; const float* LB;
    DEVI void operator()(const f32x4 (&acc)[2][2][4][2], const Unit& u, int wr, int wc, int fr, int fq) const {
        const int blk = u.pn >> 1;
        float inv[4];
#pragma unroll
        for (int j = 0; j < 4; ++j) inv[j] = exp2f(-(float)((wc & 1) * 16 + 4 * fq + j) * (13.287712379549449f / 32.f));
#pragma unroll
        for (int bj = 0; bj < 2; ++bj) { const int cb = (u.pn & 1) * 256 + 128 * bj;
            const int cc0 = cb + 32 * wc + 4 * fq;
            const int lc0 = cb + (wc >> 1) * 64 + (wc & 1) * 16 + 4 * fq;
#pragma unroll
            for (int ai = 0; ai < 2; ++ai)
#pragma unroll
                for (int m = 0; m < 4; ++m) { const int r = u.pm * BM + 128 * ai + 64 * wr + 16 * m + fr; f32x4 x1 = acc[ai][bj][m][0], x2 = acc[ai][bj][m][1];
                    if (blk <= 1) { float* LF = (float*)(ws + WS_LF) + ((size_t)blk * T + r) * 512 + cc0; const f32x4 l1 = *(const f32x4*)(LB + cc0), l2 = *(const f32x4*)(LB + cc0 + 16);
                        const f32x4 s1 = {sigmoid_(x1.x), sigmoid_(x1.y), sigmoid_(x1.z), sigmoid_(x1.w)}, s2 = {sigmoid_(x2.x), sigmoid_(x2.y), sigmoid_(x2.z), sigmoid_(x2.w)};
                        const f32x4 f1 = l1 + (1.f - l1) * s1, f2 = l2 + (1.f - l2) * s2;
                        *(f32x4*)LF = (f32x4){__logf(f1.x), __logf(f1.y), __logf(f1.z), __logf(f1.w)}; *(f32x4*)(LF + 16) = (f32x4){__logf(f2.x), __logf(f2.y), __logf(f2.z), __logf(f2.w)};
                    } else if (blk == 3 || blk == 7) { const int t = r & (SEQ - 1); rope_pair(x1, x2, (float)((wc >> 1) ? (t & 63) : (t >> 6)), inv);
                        if (blk == 3) { ::bf16* d = (::bf16*)(ws + WS_KR) + (size_t)r * 512 + lc0; *(u32x2*)d = pk4(x1 * HEAD_SCALE); *(u32x2*)(d + 32) = pk4(x2 * HEAD_SCALE); }
                        else { ::bf16* d = (::bf16*)(ws + WS_QS) + (size_t)r * 1024 + 512 + lc0; *(u32x2*)d = pk4(x1); *(u32x2*)(d + 32) = pk4(x2); }
                    } else { ::bf16* d;
                        if (blk == 2) d = (::bf16*)(ws + WS_VS) + (size_t)r * 1024 + cc0; else if (blk == 4) d = (::bf16*)(ws + WS_VS) + (size_t)r * 1024 + 512 + cc0;
                        else if (blk == 5) { d = (::bf16*)(ws + WS_QS) + (size_t)r * 1024 + cc0; x1 = silu4(x1) * HEAD_SCALE; x2 = silu4(x2) * HEAD_SCALE; }
                        else if (blk == 6) d = (::bf16*)(ws + WS_G) + (size_t)r * 1024 + cc0; else d = (::bf16*)(ws + WS_G) + (size_t)r * 1024 + 512 + cc0;
                        *(u32x2*)d = pk4(x1); *(u32x2*)(d + 16) = pk4(x2); } } }
    }
};
struct EpiResidP {
    static constexpr bool PERM = true, AFTER_DRAIN = false; float* XA; const float* gate; ::bf16* Hn; const float* ng; const float* sc; float* RSS;
    DEVI void operator()(const f32x4 (&acc)[2][2][4][2], const Unit& u, int wr, int wc, int fr, int fq) const {
        const int bi = (u.pm * BM) >> 13; const float* g = gate + (size_t)bi * 6144; const float* s2 = sc + (size_t)bi * 6144;
        float ss[2][4];
#pragma unroll
        for (int ai = 0; ai < 2; ++ai)
#pragma unroll
            for (int m = 0; m < 4; ++m) ss[ai][m] = 0.f;
#pragma unroll
        for (int bj = 0; bj < 2; ++bj) { const int c = u.pn * BM + 128 * bj + 32 * wc + 8 * fq; const f32x4 g0 = *(const f32x4*)(g + c), g1 = *(const f32x4*)(g + c + 4);
            const f32x4 m0 = *(const f32x4*)(ng + c) * (*(const f32x4*)(s2 + c) + 1.f), m1 = *(const f32x4*)(ng + c + 4) * (*(const f32x4*)(s2 + c + 4) + 1.f);
#pragma unroll
            for (int ai = 0; ai < 2; ++ai)
#pragma unroll
                for (int m = 0; m < 4; ++m) { const size_t o = (size_t)(u.pm * BM + 128 * ai + 64 * wr + 16 * m + fr) * 1024 + c; f32x4* xp = (f32x4*)(XA + o);
                    const f32x4 x0 = xp[0] + g0 * acc[ai][bj][m][0], x1 = xp[1] + g1 * acc[ai][bj][m][1]; xp[0] = x0; xp[1] = x1;
                    const u32x2 lo = pk4(x0 * m0), hi = pk4(x1 * m1); *(u32x4*)(Hn + o) = (u32x4){lo.x, lo.y, hi.x, hi.y};
                    ss[ai][m] += (x0.x * x0.x + x0.y * x0.y + x0.z * x0.z + x0.w * x0.w) + (x1.x * x1.x + x1.y * x1.y + x1.z * x1.z + x1.w * x1.w); } }
#pragma unroll
        for (int ai = 0; ai < 2; ++ai)
#pragma unroll
            for (int m = 0; m < 4; ++m) { float v = ss[ai][m]; v += __shfl_xor(v, 16); v += __shfl_xor(v, 32); if (fq == 0) RSS[(size_t)(u.pm * BM + 128 * ai + 64 * wr + 16 * m + fr) * 16 + u.pn * 4 + wc] = v; }
    }
};
struct EpiBf16P {
    static constexpr bool PERM = true, AFTER_DRAIN = false; ::bf16* O; int ld; const float* RSS; const float* shq;
    DEVI void operator()(const f32x4 (&acc)[2][2][4][2], const Unit& u, int wr, int wc, int fr, int fq) const {
        const float* sq = shq + (size_t)((u.pm * BM) >> 13) * 2048;
        float rs[2][4];
#pragma unroll
        for (int ai = 0; ai < 2; ++ai)
#pragma unroll
            for (int m = 0; m < 4; ++m) rs[ai][m] = rss_rstd(RSS + (size_t)(u.pm * BM + 128 * ai + 64 * wr + 16 * m + fr) * 16);
#pragma unroll
        for (int bj = 0; bj < 2; ++bj) { const int c = u.pn * BM + 128 * bj + 32 * wc + 8 * fq; const f32x4 q0 = *(const f32x4*)(sq + c), q1 = *(const f32x4*)(sq + c + 4);
#pragma unroll
            for (int ai = 0; ai < 2; ++ai)
#pragma unroll
                for (int m = 0; m < 4; ++m) { const u32x2 lo = pk4(acc[ai][bj][m][0] * rs[ai][m] + q0), hi = pk4(acc[ai][bj][m][1] * rs[ai][m] + q1);
                    *(u32x4*)(O + (size_t)(u.pm * BM + 128 * ai + 64 * wr + 16 * m + fr) * ld + c) = (u32x4){lo.x, lo.y, hi.x, hi.y}; } }
    }
};
template <class Epi> DEVI void run(const ::bf16* A, const ::bf16* Bt, int N, unsigned char* lds, const Epi& E) {
    Gemm g{A, Bt, TX, N, 1024}; StaticOrder S; S.init(TX, N, (int)gridDim.x, (int)blockIdx.x);
    gemm_phase<Epi, StaticOrder, true, true>((PG8_LAS unsigned char*)lds, g, S, E);
}
}
#define OPT_GEMM 1

DEVI bool phase_nonempty(int ph) {
    if (ph == 0) return true;
    if (ph == NPHASES - 1) return false;
    const int L = (ph - 1) / NPH_LAYER, s = (ph - 1) % NPH_LAYER;
    if ((L & 1) == 0 && (s == 4 || s == 5 || s == 6)) return false;
    if (OPT_GEMM && (s == 2 || s == 8 || s == 10)) return false;
    if (s == 0 && L > 0) return false;
    return true;
}
DEVI void run_phase(const Params& p, int ph, float* smem) {
    if (ph == 0) { ph_prologue(p, smem); if (OPT_GEMM) { __syncthreads(); ph_weights(p, smem); ph_subkeys(p); ph_gmlp_weights(p); } return; }
    if (ph == NPHASES - 1) return;
    const int L = (ph - 1) / NPH_LAYER, s = (ph - 1) % NPH_LAYER, jl = L >> 1; const bool even = (L & 1) == 0;
    const bf16* H = (const bf16*)(p.ws + WS_H); const float* MOD = (const float*)(p.ws + WS_MOD);
    unsigned char* lds = (unsigned char*)smem;
    { const bool split = !even && gridDim.x >= 256; if (s == (split ? 4 : 9)) ph_tables(p, L, split ? 128 : 0, split ? (int)gridDim.x - 128 : (int)gridDim.x); }
    switch (s) {
    case 0: if (L == 0) { ph_norm(p, L, 0); ph_shq(p, smem); } break;
    case 1:
            if (even) { const bf16* W = (const bf16*)(p.ws + WT_INE) + (size_t)jl * 2560 * 1024; pg8::EpiEvenP e8{p.ws}; pg8::run(H, W, 2560, lds, e8); EpiEven e{p.ws}; gemm_mfma(H, W, 2560, lds, e, true); }
            else { const bf16* W = (const bf16*)(p.ws + WT_INO) + (size_t)jl * 4608 * 1024; const float* LBl = (const float*)(p.ws + WS_LB) + L * 512; pg8::EpiOddP e8{p.ws, LBl}; pg8::run(H, W, 4608, lds, e8); EpiOdd e{p.ws, LBl}; gemm_mfma(H, W, 4608, lds, e, true); }
            break;
    case 2: break;
    case 3: if (even) { ph_gmlp(p, L, lds); __syncthreads(); ph_attn(p, L, lds); } else ph_scan1(p, L, lds); break;
    case 4: if (!even) ph_scan2(p); break;
    case 5: if (!even) ph_scan3(p, L, lds); break;
    case 6: if (!even) ph_scan4(p, L); break;
    case 7:
            { const bf16* W = (const bf16*)(p.ws + WT_OUT) + (size_t)L * 1024 * 1024; const float* gt = MOD + (size_t)L * 3 * 6144 + 2048; const float* ng = p.norm_g + (L * 2 + 1) * 1024; const float* sc2 = MOD + (size_t)L * 3 * 6144 + 4096;
              bf16* Hn = (bf16*)(p.ws + WS_H); float* RSS = (float*)(p.ws + WS_RSS) + (size_t)L * T * 16;
              pg8::EpiResidP e8{(float*)(p.ws + WS_XA), gt, Hn, ng, sc2, RSS}; pg8::run((const bf16*)(p.ws + WS_OX), W, 1024, lds, e8);
              if (L != DEPTH - 1) { EpiResid e{(float*)(p.ws + WS_XA), gt, Hn, ng, sc2, RSS}; gemm_mfma((const bf16*)(p.ws + WS_OX), W, 1024, lds, e, true); } }
            break;
    case 8: break;
    case 9:
            {
              const bf16* W = (const bf16*)(p.ws + WT_Q) + (size_t)L * 2048 * 1024; const float* RSS = (const float*)(p.ws + WS_RSS) + (size_t)L * T * 16; const float* shq = (const float*)(p.ws + WS_SHQ) + (size_t)L * 3 * 2048;
              pg8::EpiBf16P e8{(bf16*)(p.ws + WS_QP), 2048, RSS, shq}; pg8::run(H, W, 2048, lds, e8); if (L != DEPTH - 1) { EpiBf16Out e{(bf16*)(p.ws + WS_QP), 2048, RSS, shq}; gemm_mfma(H, W, 2048, lds, e, true); } }
            break;
    case 10: break;
    case 11: ph_peer_select(p, L, smem); break;
    case 12:
#if defined(PROF_GATHER)
            ph_peer_gather<true>(p, L, smem); __syncthreads();
#endif
#if defined(PROF_GDRY)
            ph_gather_dry(p, L); __syncthreads();
#endif
            ph_peer_gather<false>(p, L, smem); break;
    }
}

constexpr int LDS_BYTES = 64 + 132 * 1024;
__global__ void __launch_bounds__(NTHR) mega(Params p) {
    extern __shared__ __attribute__((aligned(16))) unsigned char lds_raw[];
    float* smem = (float*)(lds_raw + 64);
    volatile unsigned* st = (volatile unsigned*)lds_raw;
#if MK_SINGLE
    if (threadIdx.x < 16) st[threadIdx.x] = 0u;
    __syncthreads();
    XcdBarrier bar = xcd_barrier_post((unsigned*)(p.ws + WS_CTL) + 4096, st);
#endif
    for (int ph = p.ph_lo; ph < p.ph_hi; ++ph) {
        if (!phase_nonempty(ph)) continue;
        Params q = p;
        { const float** qq = (const float**)&q;
#pragma unroll
          for (int i = 0; i < 24; ++i) { const float __attribute__((address_space(1)))* gpt = (const float __attribute__((address_space(1)))*)qq[i]; asm volatile("" : "+s"(gpt)); qq[i] = (const float*)gpt; }
          { unsigned char __attribute__((address_space(1)))* gw = (unsigned char __attribute__((address_space(1)))*)q.ws; asm volatile("" : "+s"(gw)); q.ws = (unsigned char*)gw; }
          { float __attribute__((address_space(1)))* go = (float __attribute__((address_space(1)))*)q.out; asm volatile("" : "+s"(go)); q.out = (float*)go; } }
        {
            int nrep = 1;
#if defined(PROF_STEP)
            if (ph > 0 && ph < NPHASES - 1 && (ph - 1) % NPH_LAYER == PROF_STEP && (((ph - 1) / NPH_LAYER) & 1) == PROF_PAR) nrep += (p.ph_lo == 0) ? PROF_NREP : 0;
#endif
            for (int rep = 0; rep < nrep; ++rep) { if (rep) __syncthreads(); run_phase(q, ph, smem); }
        }
#if MK_SINGLE
        if (ph + 1 < p.ph_hi) xcd_barrier(bar);
#endif
    }
}

extern "C" void kernel_launch(void* const* d_in, const int* in_sizes, int n_in, void* d_out, int out_size, void* d_ws, size_t ws_size, hipStream_t stream) {
    static int grid = 0;
    if (grid == 0) {
        if (n_in != 24 || out_size != TX * D || ws_size < WS_END) { fprintf(stderr, "kernel_launch: unexpected shapes (n_in %d out %d ws %zu)\n", n_in, out_size, ws_size); grid = -1; return; }
        int dev = 0, cus = 0, per_cu = 0;
        (void)hipGetDevice(&dev); (void)hipDeviceGetAttribute(&cus, hipDeviceAttributeMultiprocessorCount, dev);
        (void)hipFuncSetAttribute((const void*)mega, hipFuncAttributeMaxDynamicSharedMemorySize, LDS_BYTES);
        if (hipOccupancyMaxActiveBlocksPerMultiprocessor(&per_cu, (const void*)mega, NTHR, LDS_BYTES) != hipSuccess || per_cu < 1) per_cu = 1;
        if (per_cu > 1) per_cu = 1;
        grid = cus * per_cu;
        fprintf(stderr, "kernel_launch: grid %d (%d CUs x %d)\n", grid, cus, per_cu);
    }
    if (grid < 0) return;
    Params p{};
    const float** pp = (const float**)&p;
    for (int i = 0; i < 24; ++i) pp[i] = (const float*)d_in[i];
    p.out = (float*)d_out; p.ws = (unsigned char*)d_ws;
#if MK_SINGLE
    (void)hipMemsetAsync((char*)d_ws + WS_CTL, 0, 1 * MiB, stream);
    p.ph_lo = 0; p.ph_hi = NPHASES;
    void* args[] = {&p};
    hipError_t e = hipLaunchCooperativeKernel((const void*)mega, dim3(grid), dim3(NTHR), args, LDS_BYTES, stream);
    if (e != hipSuccess) fprintf(stderr, "cooperative launch failed: %s (grid %d)\n", hipGetErrorString(e), grid);
#else
    for (int ph = 0; ph < NPHASES; ++ph) {
        bool ne = true;
        if (ph != 0 && ph != NPHASES - 1) { const int L = (ph - 1) / NPH_LAYER, s = (ph - 1) % NPH_LAYER; if ((L & 1) == 0 && (s == 4 || s == 5 || s == 6)) ne = false; }
        if (!ne) continue;
        p.ph_lo = ph; p.ph_hi = ph + 1;
        hipLaunchKernelGGL(mega, dim3(grid), dim3(NTHR), LDS_BYTES, stream, p);
    }
#endif
}
```

```cpp
#include <hip/hip_runtime.h>
#include <cstdio>
#include <cstdint>

#ifndef MK_SINGLE
#define MK_SINGLE 1
#endif

#define DEVI __device__ __forceinline__
#define LAS __attribute__((address_space(3)))

typedef unsigned short bf16;
typedef float f32x4 __attribute__((ext_vector_type(4)));
typedef unsigned u32x4 __attribute__((ext_vector_type(4)));
typedef unsigned u32x2 __attribute__((ext_vector_type(2)));
typedef float f32x2 __attribute__((ext_vector_type(2)));

constexpr int D = 1024, SEQ = 8192, NCTX = 256, DEPTH = 4;
constexpr int TX = 2 * SEQ, TC = 2 * NCTX, T = TX + TC;
constexpr int NSEQ = SEQ + NCTX;
constexpr int NCHUNK = NSEQ / 64;
constexpr float EPS = 1e-6f;
constexpr float LOG2E = 1.4426950408889634f;
constexpr float DIFF_SCALE = 0.125f, HEAD_SCALE = 0.08838834764831845f;
constexpr int NPH_LAYER = 13, NPHASES = 1 + DEPTH * NPH_LAYER + 1;
constexpr int NTHR = 512, NWV = NTHR / 64;

constexpr size_t MiB = 1u << 20;
constexpr size_t WS_CTL = 0;
constexpr size_t WS_MOD = 1 * MiB;
constexpr size_t WS_LB = WS_MOD + 512 * 1024, WS_LAM = WS_MOD + 768 * 1024;
constexpr size_t WS_SHQ = WS_MOD + 800 * 1024;
constexpr size_t WS_RSS = 58 * MiB;
constexpr size_t WS_WT = 2 * MiB;
constexpr size_t WS_XA = 66 * MiB;
constexpr size_t WS_H = 132 * MiB;
constexpr size_t WS_OX = 165 * MiB;
constexpr size_t WS_ACT = 198 * MiB;
constexpr size_t TB512 = (size_t)T * 512 * 2;
constexpr size_t WS_KB = WS_ACT, WS_VB = WS_ACT + TB512, WS_QB = WS_ACT + 2 * TB512, WS_UB = WS_ACT + 3 * TB512, WS_VG = WS_ACT + 4 * TB512;
constexpr size_t WS_LF = WS_ACT;
constexpr size_t WS_VS = WS_ACT + 66 * MiB;
constexpr size_t WS_KR = WS_VS + 33 * MiB;
constexpr size_t WS_QS = WS_KR + TB512;
constexpr size_t WS_G = WS_QS + 33 * MiB;
constexpr size_t WS_OFB = 390 * MiB;
constexpr size_t WS_UT = 522 * MiB;
constexpr size_t WS_DEC = 786 * MiB;
constexpr size_t WS_QP = 522 * MiB;
constexpr size_t WS_SC = 588 * MiB;
constexpr size_t WS_EID = 720 * MiB;
constexpr size_t WS_GATE = 729 * MiB;
constexpr size_t WS_R = 390 * MiB;
constexpr size_t WS_SCR = 522 * MiB;
constexpr size_t WS_TAB = 792 * MiB;
constexpr size_t WS_END = 856 * MiB;

struct Params {
    const float *x, *c, *ctx, *c_ctx, *w_ada, *b_ada, *norm_g, *w_in_even, *gmlp_ws, *gmlp_bs, *gmlp_v_gain, *diff_lambda, *diff_sub_gain,
        *w_in_odd, *hgrn_lb, *hgrn_gain, *ret_log_decay, *ret_gain, *w_out, *peer_wq, *peer_sub_keys, *peer_u, *peer_v, *final_g;
    float* out; unsigned char* ws; int ph_lo, ph_hi;
};

DEVI float bf2f(bf16 h) { return __uint_as_float((unsigned)h << 16); }
DEVI unsigned f2bf(float f) { unsigned u = __float_as_uint(f); return (u + 0x7fffu + ((u >> 16) & 1u)) >> 16; }
typedef __bf16 bf16x2n __attribute__((ext_vector_type(2)));
DEVI unsigned pk2(float lo, float hi) { const bf16x2n v = {(__bf16)lo, (__bf16)hi}; return __builtin_bit_cast(unsigned, v); }
DEVI u32x2 pk4(const f32x4 v) { u32x2 o; o.x = pk2(v.x, v.y); o.y = pk2(v.z, v.w); return o; }
DEVI float bflo(unsigned w) { return __uint_as_float(w << 16); }
DEVI float bfhi(unsigned w) { return __uint_as_float(w & 0xffff0000u); }
DEVI float wave_sum(float v) {
#pragma unroll
    for (int o = 32; o >= 1; o >>= 1) v += __shfl_xor(v, o);
    return v;
}
DEVI float wave_max(float v) {
#pragma unroll
    for (int o = 32; o >= 1; o >>= 1) v = fmaxf(v, __shfl_xor(v, o));
    return v;
}
DEVI float half_sum(float v) {
#pragma unroll
    for (int o = 16; o >= 1; o >>= 1) v += __shfl_xor(v, o);
    return v;
}
DEVI float sigmoid_(float x) { return 1.f / (1.f + __expf(-x)); }
DEVI float silu_(float x) { return x * sigmoid_(x); }
DEVI float gelu_(float x) { const float u = 1.5957691216057308f * (x + 0.044715f * x * x * x); return x / (1.f + __expf(-u)); }
DEVI int mod_index(int r) { return r < TX ? (r >> 13) : 2; }
DEVI float rss_rstd(const float* rssp) { const f32x4 a = *(const f32x4*)rssp, b = *(const f32x4*)(rssp + 4), c = *(const f32x4*)(rssp + 8), d = *(const f32x4*)(rssp + 12);
    const float s = ((a.x + a.y) + (a.z + a.w)) + ((b.x + b.y) + (b.z + b.w)) + (((c.x + c.y) + (c.z + c.w)) + ((d.x + d.y) + (d.z + d.w))); return rsqrtf(s * (1.f / 1024.f) + EPS); }
template <int L> DEVI int rope_partner(int cc) { constexpr int Q = L / 4; return ((cc % (L / 2)) < Q) ? cc + Q : cc - Q; }
template <int L> DEVI float rope_apply(int cc, float self, float partner, int grow, int gcol) {
    constexpr int Q = L / 4;
    const int sec = cc / (L / 2), c2 = cc % (L / 2), i = c2 % Q; const bool first = c2 < Q;
    const float pos = (float)(sec ? gcol : grow);
    const float inv = exp2f(-(float)i * (13.287712379549449f / (float)Q));
    const float ang = pos * inv; const float cs = __cosf(ang), sn = __sinf(ang);
    return first ? (self * cs - partner * sn) : (partner * sn + self * cs);
}
DEVI int scan_row(int b, int dir, int j) {
    if (j < NCTX) return TX + b * NCTX + (dir ? NCTX - 1 - j : j);
    const int t = j - NCTX; return b * SEQ + (dir ? SEQ - 1 - t : t);
}

#define XB_TMO 128
#define XB_XCNT(j) (256 + 64 * (j))
#define XB_XSUB(j) (1280 + 64 * (j))
#define XB_XGEN(j) (2304 + 64 * (j))
#define XB_TOP 3328
#define XB_TOPGEN 3392
#define XB_SPIN_CAP (1u << 22)
DEVI unsigned xb_ld(unsigned* p) { return __hip_atomic_load(p, __ATOMIC_RELAXED, __HIP_MEMORY_SCOPE_AGENT); }
DEVI unsigned xb_add(unsigned* p, unsigned v) { return __hip_atomic_fetch_add(p, v, __ATOMIC_RELAXED, __HIP_MEMORY_SCOPE_AGENT); }
DEVI unsigned xb_xcc_id() { return (unsigned)__builtin_amdgcn_s_getreg((3 << 11) | 20) & 0xFu; }
#define XB_SPIN(cond, bar) do { unsigned _sp = 0; while (cond) { __builtin_amdgcn_s_sleep(1); \
    if ((++_sp & 255u) == 0u) { if (xb_ld(&(bar)[XB_TMO])) break; if (_sp > XB_SPIN_CAP) { atomicAdd(&(bar)[XB_TMO], 1u); break; } } } } while (0)
struct XcdBarrier { unsigned* bar; unsigned x; volatile unsigned* st; };
DEVI XcdBarrier xcd_barrier_post(unsigned* bar, volatile unsigned* st) {
    XcdBarrier b; b.bar = bar; b.x = xb_xcc_id(); b.st = st;
    if (threadIdx.x == 0) (void)xb_add(&bar[XB_XCNT(b.x)], 1u);
    return b;
}
DEVI void xcd_barrier_complete(unsigned* bar, unsigned x, unsigned& nloc, unsigned& nx) {
    const unsigned G = gridDim.x; unsigned sum, cnt, mine, sp = 0u;
    for (;;) {
        sum = 0u; cnt = 0u; mine = 0u;
#pragma unroll
        for (unsigned j = 0; j < 16; ++j) { const unsigned c = xb_ld(&bar[XB_XCNT(j)]); sum += c; cnt += (c > 0u) ? 1u : 0u; mine = (j == x) ? c : mine; }
        if (sum == G) break;
        __builtin_amdgcn_s_sleep(1);
        if ((++sp & 255u) == 0u) { if (xb_ld(&bar[XB_TMO])) break; if (sp > XB_SPIN_CAP) { atomicAdd(&bar[XB_TMO], 1u); break; } }
    }
    nloc = mine > 0u ? mine : 1u; nx = cnt > 0u ? cnt : 1u;
}
DEVI void xcd_barrier(const XcdBarrier& b) {
    asm volatile("s_waitcnt vmcnt(0)" ::: "memory");
    __syncthreads();
    if (threadIdx.x == 0) {
        unsigned* bar = b.bar;
        __builtin_amdgcn_s_waitcnt(0);
        unsigned nloc = b.st[0], nx = b.st[1];
        if (nloc == 0u) { xcd_barrier_complete(bar, b.x, nloc, nx); b.st[0] = nloc; b.st[1] = nx; }
        const unsigned old = xb_add(&bar[XB_XSUB(b.x)], 1u);
        const unsigned gen = old / nloc;
        if (old + 1u == (gen + 1u) * nloc) {
            __builtin_amdgcn_fence(__ATOMIC_RELEASE, "agent");
            asm volatile("s_waitcnt vmcnt(0)" ::: "memory");
            const unsigned og = xb_add(&bar[XB_TOP], 1u);
            const unsigned tg = og / nx;
            if (og + 1u == (tg + 1u) * nx) xb_add(&bar[XB_TOPGEN], 1u);
            else XB_SPIN(xb_ld(&bar[XB_TOPGEN]) == tg, bar);
            __builtin_amdgcn_fence(__ATOMIC_ACQUIRE, "agent");
            xb_add(&bar[XB_XGEN(b.x)], 1u);
            asm volatile("s_waitcnt vmcnt(0)" ::: "memory");
        } else {
            XB_SPIN(xb_ld(&bar[XB_XGEN(b.x)]) == gen, bar);
            __builtin_amdgcn_fence(__ATOMIC_ACQUIRE, "agent");
            asm volatile("s_waitcnt vmcnt(0)" ::: "memory");
        }
    }
    __syncthreads();
}

DEVI int tidx() { int t = threadIdx.x; asm volatile("" : "+v"(t)); return t; }
DEVI void ph_prologue(const Params& p, float* smem) {
    float* MOD = (float*)(p.ws + WS_MOD);
    const int tid = tidx(), w = tid >> 6, lane = tid & 63;
    for (int it = blockIdx.x; it < 4 * 48; it += gridDim.x) {
        const int layer = it / 48, n0 = (it % 48) * 128;
        const float* W = p.w_ada + (size_t)layer * 1024 * 6144 + n0 + 2 * lane;
        float* sv = smem; float* red = smem + 3 * 1024;
        __syncthreads();
        for (int i = tid; i < 3 * 1024; i += NTHR) { const int v = i >> 10, k = i & 1023; sv[i] = silu_(v == 0 ? p.c[k] : v == 1 ? p.c[1024 + k] : p.c_ctx[k]); }
        __syncthreads();
        f32x2 a0 = {0.f, 0.f}, a1 = {0.f, 0.f}, a2 = {0.f, 0.f};
#pragma unroll 8
        for (int kk = 0; kk < 128; ++kk) { const int k = w * 128 + kk; const f32x2 wv = *(const f32x2*)(W + (size_t)k * 6144);
            a0 += wv * sv[k]; a1 += wv * sv[1024 + k]; a2 += wv * sv[2048 + k]; }
        *(f32x2*)(red + (w * 3 + 0) * 128 + 2 * lane) = a0; *(f32x2*)(red + (w * 3 + 1) * 128 + 2 * lane) = a1; *(f32x2*)(red + (w * 3 + 2) * 128 + 2 * lane) = a2;
        __syncthreads();
        if (tid < 384) { const int v = tid >> 7, cidx = tid & 127; float sacc = p.b_ada[layer * 6144 + n0 + cidx];
#pragma unroll
            for (int ww = 0; ww < NWV; ++ww) sacc += red[(ww * 3 + v) * 128 + cidx];
            MOD[(size_t)(layer * 3 + v) * 6144 + n0 + cidx] = sacc; }
    }
    if (blockIdx.x == 0) {
        float* LB = (float*)(p.ws + WS_LB);
        for (int ch = tid; ch < 512; ch += NTHR) {
            const float p0 = p.hgrn_lb[ch], p1 = p.hgrn_lb[512 + ch], p2 = p.hgrn_lb[1024 + ch], p3 = p.hgrn_lb[1536 + ch];
            const float m = fmaxf(fmaxf(p0, p1), fmaxf(p2, p3));
            const float e0 = __expf(p0 - m), e1 = __expf(p1 - m), e2 = __expf(p2 - m), e3 = __expf(p3 - m), s = e0 + e1 + e2 + e3;
            LB[ch] = 0.f; LB[512 + ch] = e1 / s; LB[1024 + ch] = (e1 + e2) / s; LB[1536 + ch] = (e1 + e2 + e3) / s;
        }
        if (tid < 2) {
            const float* lv = p.diff_lambda + tid * 256; float d01 = 0.f, d23 = 0.f;
            for (int i = 0; i < 64; ++i) { d01 += lv[i] * lv[64 + i]; d23 += lv[128 + i] * lv[192 + i]; }
            const float lam_init = tid == 0 ? 0.2f : 0.47071301834f;
            ((float*)(p.ws + WS_LAM))[tid] = __expf(d01) - __expf(d23) + lam_init;
        }
    }
}

DEVI void ph_shq(const Params& p, float* smem) {
    const float* MOD = (const float*)(p.ws + WS_MOD); float* SHQ = (float*)(p.ws + WS_SHQ);
    const int tid = tidx(), w = tid >> 6, lane = tid & 63;
    for (int it = blockIdx.x; it < 4 * 16; it += gridDim.x) {
        const int layer = it >> 4, n0 = (it & 15) * 128;
        const float* W = p.peer_wq + (size_t)layer * 1024 * 2048 + n0 + 2 * lane;
        float* sv = smem; float* red = smem + 3 * 1024;
        __syncthreads();
        for (int i = tid; i < 3 * 1024; i += NTHR) sv[i] = MOD[(size_t)(layer * 3 + (i >> 10)) * 6144 + 3072 + (i & 1023)];
        __syncthreads();
        f32x2 a0 = {0.f, 0.f}, a1 = {0.f, 0.f}, a2 = {0.f, 0.f};
#pragma unroll 8
        for (int kk = 0; kk < 128; ++kk) { const int k = w * 128 + kk; const f32x2 wv = *(const f32x2*)(W + (size_t)k * 2048);
            a0 += wv * sv[k]; a1 += wv * sv[1024 + k]; a2 += wv * sv[2048 + k]; }
        *(f32x2*)(red + (w * 3 + 0) * 128 + 2 * lane) = a0; *(f32x2*)(red + (w * 3 + 1) * 128 + 2 * lane) = a1; *(f32x2*)(red + (w * 3 + 2) * 128 + 2 * lane) = a2;
        __syncthreads();
        if (tid < 384) { const int v = tid >> 7, cidx = tid & 127; float sacc = 0.f;
#pragma unroll
            for (int ww = 0; ww < NWV; ++ww) sacc += red[(ww * 3 + v) * 128 + cidx];
            SHQ[(size_t)(layer * 3 + v) * 2048 + n0 + cidx] = sacc; }
    }
}
DEVI void ph_norm(const Params& p, int layer, int which) {
    float* XA = (float*)(p.ws + WS_XA); bf16* H = (bf16*)(p.ws + WS_H); const float* MOD = (const float*)(p.ws + WS_MOD);
    const int lane = tidx() & 63, gw = blockIdx.x * NWV + (tidx() >> 6), NW = gridDim.x * NWV;
    const float* g = p.norm_g + (layer * 2 + which) * 1024;
    for (int r = gw; r < T; r += NW) {
        const f32x4* xr = (const f32x4*)(r < TX ? p.x + (size_t)r * 1024 : p.ctx + (size_t)(r - TX) * 1024);
        const float* m = MOD + (size_t)(layer * 3 + mod_index(r)) * 6144 + which * 3072;
        f32x4 v[4]; float ss = 0.f;
#pragma unroll
        for (int j = 0; j < 4; ++j) { v[j] = xr[j * 64 + lane]; ss += v[j].x * v[j].x + v[j].y * v[j].y + v[j].z * v[j].z + v[j].w * v[j].w; ((f32x4*)(XA + (size_t)r * 1024))[j * 64 + lane] = v[j]; }
        const float rstd = rsqrtf(wave_sum(ss) * (1.f / 1024.f) + EPS);
#pragma unroll
        for (int j = 0; j < 4; ++j) {
            const int col = (j * 64 + lane) * 4;
            const f32x4 g4 = *(const f32x4*)(g + col), sh = *(const f32x4*)(m + col), sc = *(const f32x4*)(m + 1024 + col);
            const f32x4 h = v[j] * rstd * g4 * (sc + 1.f) + sh;
            u32x2 o; o.x = pk2(h.x, h.y); o.y = pk2(h.z, h.w);
            *(u32x2*)(H + (size_t)r * 1024 + col) = o;
        }
    }
}

DEVI void ph_scan4_naive(const Params& p, int layer) {
    const int jl = layer >> 1, lane = tidx() & 63, gw = blockIdx.x * NWV + (tidx() >> 6), NW = gridDim.x * NWV;
    const bf16* OFB = (const bf16*)(p.ws + WS_OFB); const bf16* G = (const bf16*)(p.ws + WS_G); bf16* OX = (bf16*)(p.ws + WS_OX);
    for (int r = gw; r < T; r += NW) {
#pragma unroll
        for (int j = 0; j < 4; ++j) {
            const int col = (j * 64 + lane) * 4, d = col & 127;
            const u32x2 of = *(const u32x2*)(OFB + (size_t)r * 1024 + col), ob = *(const u32x2*)(OFB + ((size_t)T + r) * 1024 + col);
            const f32x4 o = {bflo(of.x) + bflo(ob.x), bfhi(of.x) + bfhi(ob.x), bflo(of.y) + bflo(ob.y), bfhi(of.y) + bfhi(ob.y)};
            const u32x2 gg = *(const u32x2*)(G + (size_t)r * 1024 + col); const float g0 = bflo(gg.x), g1 = bfhi(gg.x), g2 = bflo(gg.y), g3 = bfhi(gg.y);
            f32x4 y;
            if (j < 2) {
                const f32x4 t = {o.x * sigmoid_(g0), o.y * sigmoid_(g1), o.z * sigmoid_(g2), o.w * sigmoid_(g3)};
                const float rn = rsqrtf(half_sum(t.x * t.x + t.y * t.y + t.z * t.z + t.w * t.w) * (1.f / 128.f) + EPS);
                const f32x4 gn = *(const f32x4*)(p.hgrn_gain + jl * 128 + d); y = t * rn * gn;
            } else {
                const float mean = half_sum(o.x + o.y + o.z + o.w) * (1.f / 128.f); const f32x4 dd = o - mean;
                const float rn = rsqrtf(half_sum(dd.x * dd.x + dd.y * dd.y + dd.z * dd.z + dd.w * dd.w) * (1.f / 128.f) + EPS);
                const f32x4 gn = *(const f32x4*)(p.ret_gain + jl * 128 + d); y = dd * rn * gn;
                y.x *= silu_(g0); y.y *= silu_(g1); y.z *= silu_(g2); y.w *= silu_(g3);
            }
            u32x2 w; w.x = pk2(y.x, y.y); w.y = pk2(y.z, y.w); *(u32x2*)(OX + (size_t)r * 1024 + col) = w;
        }
    }
}

#define KEY_INSERT(K, key) do { _Pragma("unroll") for (int _j = 15; _j >= 1; --_j) K[_j] = __builtin_amdgcn_fmed3f(K[_j - 1], K[_j], (key)); K[0] = fmaxf(K[0], (key)); } while (0)
#define TOPK_INSERT(V, I, s, id) do { \
    _Pragma("unroll") for (int _j = 15; _j >= 1; --_j) { const bool _up = (s) > V[_j - 1]; const bool _in = (s) > V[_j]; \
        I[_j] = _up ? I[_j - 1] : (_in ? (id) : I[_j]); V[_j] = _up ? V[_j - 1] : (_in ? (s) : V[_j]); } \
    { const bool _in0 = (s) > V[0]; I[0] = _in0 ? (id) : I[0]; V[0] = _in0 ? (s) : V[0]; } } while (0)
DEVI void ph_final(const Params& p) {
    const float* XA = (const float*)(p.ws + WS_XA);
    const int lane = tidx() & 63, gw = blockIdx.x * NWV + (tidx() >> 6), NW = gridDim.x * NWV;
    for (int r = gw; r < TX; r += NW) {
        const f32x4* xr = (const f32x4*)(XA + (size_t)r * 1024); f32x4 v[4]; float ss = 0.f;
#pragma unroll
        for (int j = 0; j < 4; ++j) { v[j] = xr[j * 64 + lane]; ss += v[j].x * v[j].x + v[j].y * v[j].y + v[j].z * v[j].z + v[j].w * v[j].w; }
        const float rstd = rsqrtf(wave_sum(ss) * (1.f / 1024.f) + EPS);
#pragma unroll
        for (int j = 0; j < 4; ++j) { const int col = (j * 64 + lane) * 4; *(f32x4*)(p.out + (size_t)r * 1024 + col) = v[j] * rstd * *(const f32x4*)(p.final_g + col); }
    }
}

typedef short bf16x8 __attribute__((ext_vector_type(8)));
constexpr size_t WT_INE = WS_WT, WT_INO = WS_WT + 10 * MiB, WT_OUT = WS_WT + 28 * MiB, WT_Q = WS_WT + 36 * MiB, WT_SK = WS_WT + 52 * MiB;

DEVI int perm_odd_col(int n) {
    const int blk = n >> 9; if (blk != 3 && blk != 7) return n;
    const int e = n & 127, sec = e >> 6, hlf = (e >> 5) & 1, i = e & 31; return (n & ~127) | (sec * 64 + (i >> 4) * 32 + hlf * 16 + (i & 15));
}
template <bool PERMODD> DEVI void transpose_item(const float* W, int K, int N, bf16* WT, float* scr, int item, int lane) {
    const int nblk = N / 32, kb = item / nblk, nb = item % nblk, k0 = 64 * kb, n0 = 32 * nb;
#pragma unroll 8
    for (int i = 0; i < 32; ++i) { const int kk = 2 * i + (lane >> 5); scr[kk * 33 + (lane & 31)] = W[(size_t)(k0 + kk) * N + n0 + (lane & 31)]; }
    asm volatile("s_waitcnt lgkmcnt(0)" ::: "memory"); __builtin_amdgcn_wave_barrier();
    const int c = lane & 7;
#pragma unroll
    for (int j = 0; j < 4; ++j) { const int n = (lane >> 3) + 8 * j; const float* s = scr + (8 * c) * 33 + n;
        u32x4 o; o.x = pk2(s[0 * 33], s[1 * 33]); o.y = pk2(s[2 * 33], s[3 * 33]); o.z = pk2(s[4 * 33], s[5 * 33]); o.w = pk2(s[6 * 33], s[7 * 33]);
        *(u32x4*)(WT + (size_t)(PERMODD ? perm_odd_col(n0 + n) : n0 + n) * K + k0 + 8 * c) = o; }
    asm volatile("s_waitcnt lgkmcnt(0)" ::: "memory"); __builtin_amdgcn_wave_barrier();
}
DEVI void ph_weights(const Params& p, float* smem) {
    const int wv = tidx() >> 6, lane = tidx() & 63, gw = blockIdx.x * NWV + wv, NW = gridDim.x * NWV;
    float* scr = smem + wv * (64 * 33);
    constexpr int I_E = 16 * (2560 / 32), I_O = 16 * (4608 / 32), I_W = 16 * (1024 / 32), I_Q = 16 * (2048 / 32);
    constexpr int NIT = 2 * I_E + 2 * I_O + 4 * I_W + 4 * I_Q;
    for (int it = gw; it < NIT; it += NW) {
        int r = it;
        if (r < 2 * I_E) { const int j = r / I_E; transpose_item<false>(p.w_in_even + (size_t)j * 1024 * 2560, 1024, 2560, (bf16*)(p.ws + WT_INE) + (size_t)j * 2560 * 1024, scr, r % I_E, lane); continue; } r -= 2 * I_E;
        if (r < 2 * I_O) { const int j = r / I_O; transpose_item<true>(p.w_in_odd + (size_t)j * 1024 * 4608, 1024, 4608, (bf16*)(p.ws + WT_INO) + (size_t)j * 4608 * 1024, scr, r % I_O, lane); continue; } r -= 2 * I_O;
        if (r < 4 * I_W) { const int j = r / I_W; transpose_item<false>(p.w_out + (size_t)j * 1024 * 1024, 1024, 1024, (bf16*)(p.ws + WT_OUT) + (size_t)j * 1024 * 1024, scr, r % I_W, lane); continue; } r -= 4 * I_W;
        { const int j = r / I_Q; transpose_item<false>(p.peer_wq + (size_t)j * 1024 * 2048, 1024, 2048, (bf16*)(p.ws + WT_Q) + (size_t)j * 2048 * 1024, scr, r % I_Q, lane); }
    }
}

constexpr int GEMM_BUF = 49152;
template <class Epi> DEVI void gemm_mfma(const bf16* A, const bf16* Wt, int N, unsigned char* lds, const Epi& epi, bool ctx_only) {
    const int tid = tidx(), wid = tid >> 6, lane = tid & 63, wr = wid >> 1, wc = wid & 1, fr = lane & 15, fq = lane >> 4;
    const int NT = N / 128;
    const int G = gridDim.x, nloc = G >> 3, xcd = blockIdx.x & 7, loc = blockIdx.x >> 3;
    const int bm = nloc >> 2, nmg = (64 + bm - 1) / bm, nng = NT >> 2, nmain = nmg * nng, nrounds = (nmain + 7) >> 3;
    int arow[4], ach[4], brow[2], bch[2];
#pragma unroll
    for (int i = 0; i < 4; ++i) { const int idx = tid + NTHR * i; arow[i] = idx >> 3; ach[i] = idx & 7; }
#pragma unroll
    for (int i = 0; i < 2; ++i) { const int idx = tid + NTHR * i; brow[i] = idx >> 3; bch[i] = idx & 7; }
    const int sw = fr & 7;
    for (int rd = ctx_only ? nrounds : 0; rd <= nrounds; ++rd) {
        int tm, tn;
        if (rd < nrounds) { const int sblk = rd * 8 + xcd; if (sblk >= nmain) continue; const int mg = sblk / nng, ng = sblk % nng; tm = mg * bm + (loc >> 2); tn = ng * 4 + (loc & 3); if (tm >= 64) continue; }
        else { const int t = G - 1 - (int)blockIdx.x; if (t >= 2 * NT) continue; tm = 64 + t / NT; tn = t % NT; }
        const int r0 = tm * 256, n0 = tn * 128;
        const bf16* Ag = A + (size_t)r0 * 1024; const bf16* Wg = Wt + (size_t)n0 * 1024;
        f32x4 acc[4][4];
#pragma unroll
        for (int a = 0; a < 4; ++a)
#pragma unroll
            for (int b = 0; b < 4; ++b) acc[a][b] = (f32x4){0.f, 0.f, 0.f, 0.f};
        u32x4 ra[4], rb[2];
#pragma unroll
        for (int i = 0; i < 4; ++i) ra[i] = *(const u32x4*)(Ag + (size_t)arow[i] * 1024 + ach[i] * 8);
#pragma unroll
        for (int i = 0; i < 2; ++i) rb[i] = *(const u32x4*)(Wg + (size_t)brow[i] * 1024 + bch[i] * 8);
        __syncthreads();
#pragma unroll
        for (int i = 0; i < 4; ++i) *(u32x4*)(lds + arow[i] * 128 + ((ach[i] ^ (arow[i] & 7)) << 4)) = ra[i];
#pragma unroll
        for (int i = 0; i < 2; ++i) *(u32x4*)(lds + 32768 + brow[i] * 128 + ((bch[i] ^ (brow[i] & 7)) << 4)) = rb[i];
        __syncthreads();
        for (int kt = 0; kt < 16; ++kt) {
            const int buf = kt & 1; unsigned char* la = lds + buf * GEMM_BUF; unsigned char* lb = la + 32768;
            if (kt + 1 < 16) {
#pragma unroll
                for (int i = 0; i < 4; ++i) ra[i] = *(const u32x4*)(Ag + (size_t)arow[i] * 1024 + (kt + 1) * 64 + ach[i] * 8);
#pragma unroll
                for (int i = 0; i < 2; ++i) rb[i] = *(const u32x4*)(Wg + (size_t)brow[i] * 1024 + (kt + 1) * 64 + bch[i] * 8);
            }
#pragma unroll
            for (int ks = 0; ks < 2; ++ks) {
                bf16x8 af[4], wf[4];
                const int ch = ((ks * 4 + fq) ^ sw) << 4;
#pragma unroll
                for (int m = 0; m < 4; ++m) af[m] = *(const bf16x8*)(la + (wr * 64 + m * 16 + fr) * 128 + ch);
#pragma unroll
                for (int n = 0; n < 4; ++n) wf[n] = *(const bf16x8*)(lb + (wc * 64 + n * 16 + fr) * 128 + ch);
#pragma unroll
                for (int m = 0; m < 4; ++m)
#pragma unroll
                    for (int n = 0; n < 4; ++n) acc[m][n] = __builtin_amdgcn_mfma_f32_16x16x32_bf16(wf[n], af[m], acc[m][n], 0, 0, 0);
            }
            if (kt + 1 < 16) {
                unsigned char* wa = lds + (buf ^ 1) * GEMM_BUF;
#pragma unroll
                for (int i = 0; i < 4; ++i) *(u32x4*)(wa + arow[i] * 128 + ((ach[i] ^ (arow[i] & 7)) << 4)) = ra[i];
#pragma unroll
                for (int i = 0; i < 2; ++i) *(u32x4*)(wa + 32768 + brow[i] * 128 + ((bch[i] ^ (brow[i] & 7)) << 4)) = rb[i];
            }
            __syncthreads();
        }
        epi(acc, r0 + wr * 64, n0 + wc * 64, fr, fq);
    }
}

template <int QTR> DEVI void rope_tile(f32x4 (&a)[4], int t, int sec128, int fq) {
    const int grow = t >> 6, gcol = t & 63;
    if (QTR == 16) {
#pragma unroll
        for (int s = 0; s < 2; ++s) { const float pos = (float)(s ? gcol : grow);
#pragma unroll
            for (int j = 0; j < 4; ++j) { const int i = fq * 4 + j; const float ang = pos * exp2f(-(float)i * (13.287712379549449f / 16.f)); const float cs = __cosf(ang), sn = __sinf(ang);
                const float x1 = a[2 * s][j], x2 = a[2 * s + 1][j]; a[2 * s][j] = x1 * cs - x2 * sn; a[2 * s + 1][j] = x1 * sn + x2 * cs; } }
    } else {
        const float pos = (float)(sec128 ? gcol : grow);
#pragma unroll
        for (int h = 0; h < 2; ++h)
#pragma unroll
            for (int j = 0; j < 4; ++j) { const int i = h * 16 + fq * 4 + j; const float ang = pos * exp2f(-(float)i * (13.287712379549449f / 32.f)); const float cs = __cosf(ang), sn = __sinf(ang);
                const float x1 = a[h][j], x2 = a[h + 2][j]; a[h][j] = x1 * cs - x2 * sn; a[h + 2][j] = x1 * sn + x2 * cs; }
    }
}
struct EpiEven {
    unsigned char* ws;
    DEVI void operator()(f32x4 (&acc)[4][4], int row0, int col0, int fr, int fq) const {
        const int blk = col0 >> 9, cc0 = col0 & 511;
        bf16* dst = (bf16*)(ws + (blk == 0 ? WS_KB : blk == 1 ? WS_VB : blk == 2 ? WS_UB : blk == 3 ? WS_VG : WS_QB));
#pragma unroll
        for (int m = 0; m < 4; ++m) {
            const int r = row0 + m * 16 + fr;
            if (blk == 0 || blk == 4) {
                if (r < TX) rope_tile<16>(acc[m], r & (SEQ - 1), 0, fq);
                if (blk == 4) {
#pragma unroll
                    for (int n = 0; n < 4; ++n) acc[m][n] = acc[m][n] * (DIFF_SCALE * LOG2E); }
            } else if (blk == 2 || blk == 3) {
#pragma unroll
                for (int n = 0; n < 4; ++n) { acc[m][n].x = gelu_(acc[m][n].x); acc[m][n].y = gelu_(acc[m][n].y); acc[m][n].z = gelu_(acc[m][n].z); acc[m][n].w = gelu_(acc[m][n].w); }
            }
#pragma unroll
            for (int n = 0; n < 4; ++n) *(u32x2*)(dst + (size_t)r * 512 + cc0 + n * 16 + fq * 4) = pk4(acc[m][n]);
        }
    }
};
struct EpiOdd {
    unsigned char* ws; const float* LB;
    DEVI void operator()(f32x4 (&acc)[4][4], int row0, int col0, int fr, int fq) const {
        const int blk = col0 >> 9, cc0 = col0 & 511;
#pragma unroll
        for (int m = 0; m < 4; ++m) {
            const int r = row0 + m * 16 + fr;
            if (blk <= 1) {
                float* LF = (float*)(ws + WS_LF) + ((size_t)blk * T + r) * 512 + cc0;
#pragma unroll
                for (int n = 0; n < 4; ++n) { const f32x4 lb = *(const f32x4*)(LB + cc0 + n * 16 + fq * 4); f32x4 o;
                    o.x = __logf(lb.x + (1.f - lb.x) * sigmoid_(acc[m][n].x)); o.y = __logf(lb.y + (1.f - lb.y) * sigmoid_(acc[m][n].y));
                    o.z = __logf(lb.z + (1.f - lb.z) * sigmoid_(acc[m][n].z)); o.w = __logf(lb.w + (1.f - lb.w) * sigmoid_(acc[m][n].w));
                    *(f32x4*)(LF + n * 16 + fq * 4) = o; }
            } else {
                bf16* dst; float sc = 1.f;
                switch (blk) {
                case 2: dst = (bf16*)(ws + WS_VS) + (size_t)r * 1024 + cc0; break;
                case 3: dst = (bf16*)(ws + WS_KR) + (size_t)r * 512 + cc0; sc = HEAD_SCALE; break;
                case 4: dst = (bf16*)(ws + WS_VS) + (size_t)r * 1024 + 512 + cc0; break;
                case 5: dst = (bf16*)(ws + WS_QS) + (size_t)r * 1024 + cc0; sc = HEAD_SCALE; break;
                case 6: dst = (bf16*)(ws + WS_G) + (size_t)r * 1024 + cc0; break;
                case 7: dst = (bf16*)(ws + WS_QS) + (size_t)r * 1024 + 512 + cc0; break;
                default: dst = (bf16*)(ws + WS_G) + (size_t)r * 1024 + 512 + cc0; break;
                }
                if (blk == 5) {
#pragma unroll
                    for (int n = 0; n < 4; ++n) { acc[m][n].x = silu_(acc[m][n].x); acc[m][n].y = silu_(acc[m][n].y); acc[m][n].z = silu_(acc[m][n].z); acc[m][n].w = silu_(acc[m][n].w); } }
#pragma unroll
                for (int n = 0; n < 4; ++n) *(u32x2*)(dst + ((blk == 3 || blk == 7) ? (n & 1) * 32 + (n >> 1) * 16 : n * 16) + fq * 4) = pk4(acc[m][n] * sc);
            }
        }
    }
};
struct EpiResid {
    float* XA; const float* gate; bf16* Hn; const float* ng; const float* sc; float* RSS;
    DEVI void operator()(f32x4 (&acc)[4][4], int row0, int col0, int fr, int fq) const {
        const int mi = mod_index(row0); const float* g = gate + (size_t)mi * 6144 + col0 + fq * 4; const float* s2 = sc + (size_t)mi * 6144 + col0 + fq * 4;
        float ss[4] = {0.f, 0.f, 0.f, 0.f};
#pragma unroll
        for (int n = 0; n < 4; ++n) { const f32x4 gv = *(const f32x4*)(g + n * 16); const f32x4 gam = *(const f32x4*)(ng + col0 + fq * 4 + n * 16) * (*(const f32x4*)(s2 + n * 16) + 1.f);
#pragma unroll
            for (int m = 0; m < 4; ++m) { const size_t o = (size_t)(row0 + m * 16 + fr) * 1024 + col0 + n * 16 + fq * 4; f32x4* xp = (f32x4*)(XA + o); const f32x4 x = *xp + gv * acc[m][n]; *xp = x;
                *(u32x2*)(Hn + o) = pk4(x * gam); ss[m] += x.x * x.x + x.y * x.y + x.z * x.z + x.w * x.w; } }
#pragma unroll
        for (int m = 0; m < 4; ++m) { float v = ss[m]; v += __shfl_xor(v, 16); v += __shfl_xor(v, 32); if (fq == 0) RSS[(size_t)(row0 + m * 16 + fr) * 16 + (col0 >> 6)] = v; }
    }
};
struct EpiBf16Out {
    bf16* O; int ld; const float* RSS; const float* shq;
    DEVI void operator()(f32x4 (&acc)[4][4], int row0, int col0, int fr, int fq) const {
        const float* sq = shq + (size_t)mod_index(row0) * 2048 + col0 + fq * 4;
#pragma unroll
        for (int m = 0; m < 4; ++m) { const float rs = rss_rstd(RSS + (size_t)(row0 + m * 16 + fr) * 16);
#pragma unroll
            for (int n = 0; n < 4; ++n) *(u32x2*)(O + (size_t)(row0 + m * 16 + fr) * ld + col0 + n * 16 + fq * 4) = pk4(acc[m][n] * rs + *(const f32x4*)(sq + n * 16)); }
    }
};

typedef float f32x16 __attribute__((ext_vector_type(16)));
typedef short s16x4 __attribute__((ext_vector_type(4)));
#define KSWZ(row, colB) ((row) * 256 + ((colB) ^ (((row) & 7) << 4)))
#define SBAR() __builtin_amdgcn_sched_barrier(0)
constexpr int SHM_V = 64 * 128 * 2, SHM_K = 64 * 128 * 2;
constexpr float ATT_THR = 8.f;
DEVI int crow(int r, int hi) { return (r & 3) + 8 * (r >> 2) + 4 * hi; }
DEVI unsigned cvtpk(float lo, float hi) { unsigned r; asm volatile("v_cvt_pk_bf16_f32 %0, %1, %2" : "=v"(r) : "v"(lo), "v"(hi)); return r; }
DEVI bf16 f2bf_hw(float x) { return __builtin_bit_cast(unsigned short, (__bf16)x); }
DEVI void partialSM(f32x16& p0, f32x16& p1, float& m_reg, float& mn, float& alpha) {
    float pmax = p0[0];
#pragma unroll
    for (int r = 1; r < 16; ++r) pmax = fmaxf(pmax, p0[r]);
#pragma unroll
    for (int r = 0; r < 16; ++r) pmax = fmaxf(pmax, p1[r]);
    { auto rr = __builtin_amdgcn_permlane32_swap(__float_as_uint(pmax), __float_as_uint(pmax), false, false);
      pmax = fmaxf(__uint_as_float(rr[0]), __uint_as_float(rr[1])); }
    if (__builtin_expect(__all(pmax - m_reg <= ATT_THR), 1)) { mn = m_reg; alpha = 1.f; }
    else { mn = fmaxf(m_reg, pmax); alpha = __builtin_amdgcn_exp2f(m_reg - mn); m_reg = mn; }
#pragma unroll
    for (int r = 0; r < 16; ++r) { p0[r] -= mn; p1[r] -= mn; }
#pragma unroll
    for (int r = 0; r < 16; ++r) p0[r] = __builtin_amdgcn_exp2f(p0[r]);
}
DEVI void finishSM(f32x16& p0, f32x16& p1, float alpha, float& l_reg, bf16x8& pa0, bf16x8& pa1, bf16x8& pa2, bf16x8& pa3) {
#pragma unroll
    for (int r = 0; r < 16; ++r) p1[r] = __builtin_amdgcn_exp2f(p1[r]);
    float ps = 0.f;
#pragma unroll
    for (int r = 0; r < 16; ++r) ps += p0[r];
#pragma unroll
    for (int r = 0; r < 16; ++r) ps += p1[r];
    { auto rr = __builtin_amdgcn_permlane32_swap(__float_as_uint(ps), __float_as_uint(ps), false, false);
      ps = __uint_as_float(rr[0]) + __uint_as_float(rr[1]); }
    l_reg = l_reg * alpha + ps;
#define PK4(P, BASE, OUT) do { unsigned a0 = cvtpk(P[BASE + 0], P[BASE + 1]), a1 = cvtpk(P[BASE + 2], P[BASE + 3]);   \
    unsigned b0 = cvtpk(P[BASE + 4], P[BASE + 5]), b1 = cvtpk(P[BASE + 6], P[BASE + 7]);                              \
    auto r0 = __builtin_amdgcn_permlane32_swap(a0, b0, false, false); auto r1 = __builtin_amdgcn_permlane32_swap(a1, b1, false, false); \
    u32x4 w = {r0[0], r1[0], r0[1], r1[1]}; OUT = *reinterpret_cast<bf16x8*>(&w); } while (0)
    PK4(p0, 0, pa0); PK4(p0, 8, pa1); PK4(p1, 0, pa2); PK4(p1, 8, pa3);
#undef PK4
}
DEVI void qkt(f32x16& p0, f32x16& p1, const unsigned char* Ks, const bf16x8* qr, int r32, int hi, int cb0) {
    p0 = f32x16{}; p1 = f32x16{};
#pragma unroll
    for (int d0 = 0; d0 < 4; ++d0) { const int cb = cb0 + (d0 * 16 + hi * 8) * 2;
        const bf16x8 b0 = *reinterpret_cast<const bf16x8*>(Ks + KSWZ(r32, cb));
        const bf16x8 b1 = *reinterpret_cast<const bf16x8*>(Ks + KSWZ(32 + r32, cb));
        p0 = __builtin_amdgcn_mfma_f32_32x32x16_bf16(b0, qr[d0], p0, 0, 0, 0);
        p1 = __builtin_amdgcn_mfma_f32_32x32x16_bf16(b1, qr[d0], p1, 0, 0, 0); }
}
DEVI int v_st(int k, int c) { const int kk = (k & ~0xC) | ((k & 4) << 1) | ((k & 8) >> 1); return ((kk >> 3) * 4 + (c >> 5)) * 512 + ((kk & 7) * 32 + (c & 31)) * 2; }
DEVI int v_rd_base(int lane) { return ((lane & 3) << 3) | (((lane >> 2) & 3) << 6) | (((lane >> 4) & 1) << 5) | (((lane >> 5) & 1) << 8); }
constexpr int v_rd_off(int d0, int ks, int half) { return d0 * 512 + ks * 4096 + half * 2048; }
template <int OFF> DEVI s16x4 tr_read(int vb) { s16x4 r; asm volatile("ds_read_b64_tr_b16 %0, %1 offset:%2" : "=&v"(r) : "v"(vb), "i"(OFF) : "memory"); return r; }
template <int D0> DEVI void pv_one(f32x16& od, int vb, bf16x8 pa0, bf16x8 pa1, bf16x8 pa2, bf16x8 pa3) {
    const s16x4 l0 = tr_read<v_rd_off(D0, 0, 0)>(vb), h0 = tr_read<v_rd_off(D0, 0, 1)>(vb), l1 = tr_read<v_rd_off(D0, 1, 0)>(vb), h1 = tr_read<v_rd_off(D0, 1, 1)>(vb);
    const s16x4 l2 = tr_read<v_rd_off(D0, 2, 0)>(vb), h2 = tr_read<v_rd_off(D0, 2, 1)>(vb), l3 = tr_read<v_rd_off(D0, 3, 0)>(vb), h3 = tr_read<v_rd_off(D0, 3, 1)>(vb);
    asm volatile("s_waitcnt lgkmcnt(0)" ::: "memory"); SBAR();
#define PKV(L, H) (bf16x8){L[0], L[1], L[2], L[3], H[0], H[1], H[2], H[3]}
    od = __builtin_amdgcn_mfma_f32_32x32x16_bf16(pa0, PKV(l0, h0), od, 0, 0, 0);
    od = __builtin_amdgcn_mfma_f32_32x32x16_bf16(pa1, PKV(l1, h1), od, 0, 0, 0);
    od = __builtin_amdgcn_mfma_f32_32x32x16_bf16(pa2, PKV(l2, h2), od, 0, 0, 0);
    od = __builtin_amdgcn_mfma_f32_32x32x16_bf16(pa3, PKV(l3, h3), od, 0, 0, 0);
#undef PKV
}
DEVI void pv_d0(f32x16* o, int vb, bf16x8 pa0, bf16x8 pa1, bf16x8 pa2, bf16x8 pa3) {
    pv_one<0>(o[0], vb, pa0, pa1, pa2, pa3); pv_one<1>(o[1], vb, pa0, pa1, pa2, pa3); pv_one<2>(o[2], vb, pa0, pa1, pa2, pa3); pv_one<3>(o[3], vb, pa0, pa1, pa2, pa3);
}
DEVI void attn_unit(const Params& p, int jl, int b, int h, int q0row, int nxt, int NT, unsigned char* lds, float lam, float lam_init) {
    const int tid = tidx(), wid = tid >> 6, lane = tid & 63, r32 = lane & 31, hi = lane >> 5, rg = wid >> 1, st = wid & 1;
    const bf16* QB = (const bf16*)(p.ws + WS_QB); const bf16* KB = (const bf16*)(p.ws + WS_KB); const bf16* VB = (const bf16*)(p.ws + WS_VB); bf16* OX = (bf16*)(p.ws + WS_OX);
    unsigned char* V_lds = lds; unsigned char* K_lds = lds + 2 * SHM_V;
    float* wsl = (float*)(lds + 2 * SHM_V + 2 * SHM_K) + wid * 64; float* li_l = wsl; float* al_l = wsl + 32;
    float m_reg = -1e30f, l_reg = 0.f; f32x16 o[4] = {}; bf16x8 qr[4];
    { const bf16* Qw = QB + (size_t)(q0row + rg * 32 + r32) * 512 + h * 128 + st * 64 + hi * 8;
#pragma unroll
      for (int d0 = 0; d0 < 4; ++d0) qr[d0] = *reinterpret_cast<const bf16x8*>(Qw + d0 * 16); }
    const int cb0 = st * 128;
    const int sr = tid >> 4, sc = (tid & 15) * 8, vst0 = v_st(sr, sc), vst1 = v_st(32 + sr, sc);
    const int vb0 = (int)(uintptr_t)V_lds + v_rd_base(lane);
    const bf16* Kx = KB + (size_t)(b * SEQ) * 512 + h * 128; const bf16* Kc = KB + (size_t)(TX + b * NCTX) * 512 + h * 128;
    const bf16* Vx = VB + (size_t)(b * SEQ) * 512 + h * 128; const bf16* Vc = VB + (size_t)(TX + b * NCTX) * 512 + h * 128;
    struct { bf16x8 vs0, vs1, ks0, ks1; } sr_[2];
#define TROW(j) ((j) < nxt ? (size_t)(j) * 64 : (size_t)((j) - nxt) * 64)
#define SLOAD(i, j) do { const bool inx_ = (j) < nxt; const bf16* Kh_ = (inx_ ? Kx : Kc) + TROW(j) * 512; const bf16* Vh_ = (inx_ ? Vx : Vc) + TROW(j) * 512; \
    sr_[i].vs0 = *(const bf16x8*)(Vh_ + (size_t)sr * 512 + sc); sr_[i].vs1 = *(const bf16x8*)(Vh_ + (size_t)(32 + sr) * 512 + sc); \
    sr_[i].ks0 = *(const bf16x8*)(Kh_ + (size_t)sr * 512 + sc); sr_[i].ks1 = *(const bf16x8*)(Kh_ + (size_t)(32 + sr) * 512 + sc); } while (0)
#define SWRITE(bb, i) do { *(bf16x8*)(V_lds + (bb) * SHM_V + vst0) = sr_[i].vs0; *(bf16x8*)(V_lds + (bb) * SHM_V + vst1) = sr_[i].vs1; const int kc = sc * 2; \
    *(bf16x8*)(K_lds + (bb) * SHM_K + KSWZ(sr, kc)) = sr_[i].ks0; *(bf16x8*)(K_lds + (bb) * SHM_K + KSWZ(32 + sr, kc)) = sr_[i].ks1; } while (0)
#define SWAIT() asm volatile("s_waitcnt vmcnt(4)" ::: "memory")
#define RESC(a) do { if (__any((a) < 1.f)) { if (hi == 0) al_l[r32] = (a); asm volatile("s_waitcnt lgkmcnt(0)" ::: "memory"); \
    _Pragma("unroll") for (int d = 0; d < 4; ++d) _Pragma("unroll") for (int r = 0; r < 16; ++r) o[d][r] *= al_l[crow(r, hi)]; } } while (0)
    f32x16 pA0, pA1, pB0, pB1; float mnA, mnB, alA, alB; bf16x8 pa0, pa1, pa2, pa3;
    constexpr int SE = 0, SO = 1;
    __syncthreads();
    SLOAD(SE, 0); asm volatile("s_waitcnt vmcnt(0)" ::: "memory"); SWRITE(0, SE); __syncthreads();
    qkt(pA0, pA1, K_lds, qr, r32, hi, cb0); partialSM(pA0, pA1, m_reg, mnA, alA);
    SLOAD(SO, 1); if (2 < NT) SLOAD(SE, 2);
    SWAIT(); SWRITE(1, SO); __syncthreads();
    for (int j = 1; j + 1 < NT; j += 2) {
        SBAR(); qkt(pB0, pB1, K_lds + SHM_K, qr, r32, hi, cb0);
        finishSM(pA0, pA1, alA, l_reg, pa0, pa1, pa2, pa3); SBAR();
        SLOAD(SO, j + 2); SBAR();
        pv_d0(o, vb0, pa0, pa1, pa2, pa3); partialSM(pB0, pB1, m_reg, mnB, alB);
        __syncthreads(); SWAIT(); SWRITE(0, SE);
        RESC(alB); __syncthreads();
        SBAR(); qkt(pA0, pA1, K_lds, qr, r32, hi, cb0);
        finishSM(pB0, pB1, alB, l_reg, pa0, pa1, pa2, pa3); SBAR();
        if (j + 3 < NT) SLOAD(SE, j + 3); SBAR();
        pv_d0(o, vb0 + SHM_V, pa0, pa1, pa2, pa3); partialSM(pA0, pA1, m_reg, mnA, alA);
        __syncthreads(); SWAIT(); SWRITE(1, SO);
        RESC(alA); __syncthreads();
    }
    SBAR(); qkt(pB0, pB1, K_lds + SHM_K, qr, r32, hi, cb0);
    finishSM(pA0, pA1, alA, l_reg, pa0, pa1, pa2, pa3); SBAR();
    pv_d0(o, vb0, pa0, pa1, pa2, pa3); partialSM(pB0, pB1, m_reg, mnB, alB);
    __syncthreads(); RESC(alB);
    finishSM(pB0, pB1, alB, l_reg, pa0, pa1, pa2, pa3); SBAR();
    pv_d0(o, vb0 + SHM_V, pa0, pa1, pa2, pa3);
    if (hi == 0) li_l[r32] = l_reg;
    asm volatile("s_waitcnt lgkmcnt(0)" ::: "memory");
    float rli[16];
#pragma unroll
    for (int r = 0; r < 16; ++r) rli[r] = __builtin_amdgcn_rcpf(li_l[crow(r, hi)]);
    __syncthreads();
    float* X = (float*)lds + rg * (32 * 128);
    if (st == 1) {
#pragma unroll
        for (int r = 0; r < 16; ++r)
#pragma unroll
            for (int d0 = 0; d0 < 4; ++d0) X[crow(r, hi) * 128 + d0 * 32 + r32] = o[d0][r] * rli[r] * lam;
    }
    __syncthreads();
    if (st == 0) {
        float ss[16];
#pragma unroll
        for (int r = 0; r < 16; ++r) { float s2 = 0.f;
#pragma unroll
            for (int d0 = 0; d0 < 4; ++d0) { const float v = o[d0][r] * rli[r] - X[crow(r, hi) * 128 + d0 * 32 + r32]; o[d0][r] = v; s2 += v * v; }
            ss[r] = s2; }
#pragma unroll
        for (int off = 16; off >= 1; off >>= 1)
#pragma unroll
            for (int r = 0; r < 16; ++r) ss[r] += __shfl_xor(ss[r], off);
        float gn[4];
#pragma unroll
        for (int d0 = 0; d0 < 4; ++d0) gn[d0] = p.diff_sub_gain[jl * 128 + d0 * 32 + r32] * (1.f - lam_init);
#pragma unroll
        for (int r = 0; r < 16; ++r) { const float rn = rsqrtf(ss[r] * (1.f / 128.f) + EPS); bf16* orow = OX + (size_t)(q0row + rg * 32 + crow(r, hi)) * 1024 + 512 + h * 128 + r32;
#pragma unroll
            for (int d0 = 0; d0 < 4; ++d0) orow[d0 * 32] = (bf16)f2bf(o[d0][r] * rn * gn[d0]); }
    }
#undef TROW
#undef SLOAD
#undef SWRITE
#undef SWAIT
#undef RESC
}
DEVI void ph_attn(const Params& p, int layer, unsigned char* lds) {
    const int jl = layer >> 1; const float lam = ((const float*)(p.ws + WS_LAM))[jl], lam_init = jl == 0 ? 0.2f : 0.47071301834f;
    const int G = gridDim.x, nloc = G >> 3, xcd = blockIdx.x & 7, loc = blockIdx.x >> 3, b = xcd >> 2, h = xcd & 3;
    for (int u = loc; u < 66; u += nloc) {
        if (u < 64) attn_unit(p, jl, b, h, b * SEQ + u * 128, 128, NCHUNK, lds, lam, lam_init);
        else attn_unit(p, jl, b, h, TX + b * NCTX + (u - 64) * 128, 0, 4, lds, lam, lam_init);
    }
}

typedef float f32x16v __attribute__((ext_vector_type(16)));
typedef float f32x32v __attribute__((ext_vector_type(32)));
typedef unsigned u32x6 __attribute__((ext_vector_type(6)));
constexpr size_t TAB_V = 12 * MiB, TAB_SCL = 24 * MiB;
DEVI void ph_tables(const Params& p, int layer, int b0, int nb) {
    if ((int)blockIdx.x < b0 || (int)blockIdx.x >= b0 + nb) return;
    const int tid = tidx(), lane = tid & 63, g = lane & 31, hf = lane >> 5, gw = ((int)blockIdx.x - b0) * NWV + (tid >> 6), NW = nb * NWV;
    float* SCL = (float*)(p.ws + WS_TAB + TAB_SCL);
    for (int rp = gw; rp < 16384; rp += NW) {
        const int row = 2 * rp + hf, tab = row >> 14, e = row & 16383;
        const f32x4* src = (const f32x4*)((tab ? p.peer_v : p.peer_u) + ((size_t)layer * 16384 + e) * 1024 + 32 * g);
        f32x4 x[8]; float am = 0.f;
#pragma unroll
        for (int i = 0; i < 8; ++i) { x[i] = src[i]; am = fmaxf(am, fmaxf(fmaxf(fabsf(x[i].x), fabsf(x[i].y)), fmaxf(fabsf(x[i].z), fabsf(x[i].w)))); }
        am = fmaxf(am, __shfl_xor(am, 16)); am = fmaxf(am, __shfl_xor(am, 8)); am = fmaxf(am, __shfl_xor(am, 4)); am = fmaxf(am, __shfl_xor(am, 2)); am = fmaxf(am, __shfl_xor(am, 1));
        const float e2 = am > 0.f ? floorf(log2f(7.5f / am)) : 0.f; const float sc = exp2f(e2);
        f32x16v a, bb;
#pragma unroll
        for (int i = 0; i < 8; ++i) { a[2 * i] = x[i].x * sc; bb[2 * i] = x[i].y * sc; a[2 * i + 1] = x[i].z * sc; bb[2 * i + 1] = x[i].w * sc; }
        const u32x6 w = __builtin_amdgcn_cvt_scalef32_2xpk16_fp6_f32(a, bb, 1.0f);
        unsigned char* dst = p.ws + WS_TAB + (size_t)tab * TAB_V + (size_t)e * 768 + 8 * g;
        *(u32x2*)dst = (u32x2){w[0], w[1]}; *(u32x2*)(dst + 256) = (u32x2){w[2], w[3]}; *(u32x2*)(dst + 512) = (u32x2){w[4], w[5]};
        if (g == 0) SCL[row] = exp2f(-e2);
    }
}
#define GAS __attribute__((address_space(1)))
DEVI u32x2 gld8(const unsigned char* p) { return *(const GAS u32x2*)p; }
DEVI float row16_sum(float d) {
    d += __builtin_bit_cast(float, __builtin_amdgcn_update_dpp(0, __builtin_bit_cast(int, d), 0xB1, 0xF, 0xF, true));
    d += __builtin_bit_cast(float, __builtin_amdgcn_update_dpp(0, __builtin_bit_cast(int, d), 0x4E, 0xF, 0xF, true));
    d += __builtin_bit_cast(float, __builtin_amdgcn_update_dpp(0, __builtin_bit_cast(int, d), 0x141, 0xF, 0xF, true));
    d += __builtin_bit_cast(float, __builtin_amdgcn_update_dpp(0, __builtin_bit_cast(int, d), 0x140, 0xF, 0xF, true));
    return d;
}
DEVI float gelu_fast(float x) { const float u = 1.5957691216057308f * (x + 0.044715f * x * x * x); return x * __builtin_amdgcn_rcpf(1.f + __expf(-u)); }
#if defined(PROF_STEP)
#define GNJ 1
#else
#define GNJ 2
#endif
template <bool DRY> DEVI void ph_peer_gather(const Params& p, int layer, float* smem) {
    const bf16* H = (const bf16*)(p.ws + WS_H); float* XA = (float*)(p.ws + WS_XA); const int* EID = (const int*)(p.ws + WS_EID); const float* GATE = (const float*)(p.ws + WS_GATE);
    const float* MOD = (const float*)(p.ws + WS_MOD);
    const unsigned char* TU = p.ws + WS_TAB; const unsigned char* TV = p.ws + WS_TAB + TAB_V; const float* SCL = (const float*)(p.ws + WS_TAB + TAB_SCL);
    const int tid = tidx(), lane = tid & 63, g = lane & 31, hf = lane >> 5, gw = blockIdx.x * NWV + (tid >> 6), NW = gridDim.x * NWV, nrow = layer == DEPTH - 1 ? TX : T;
    const bool last = layer == DEPTH - 1;
    const int nmain = (nrow / NW) * NW, ntail = nrow - nmain, split = (ntail > 0 && ntail * 4 == NW) ? 1 : 0, nitem = nmain / NW + (ntail > 0 ? 1 : 0);
    for (int itx = 0; itx < nitem; ++itx) {
        const bool tailq = split && itx == nmain / NW;
        const int r = tailq ? nmain + (gw >> 2) : gw + itx * NW; const int s0 = tailq ? (gw & 3) * 32 : 0, s1 = tailq ? s0 + 32 : 128;
        if (!tailq && r >= nrow) continue;
        float hv[32];
        { const u32x4* hp = (const u32x4*)(H + (size_t)r * 1024 + 32 * g); const float rs2 = rss_rstd((const float*)(p.ws + WS_RSS) + ((size_t)layer * T + r) * 16);
          const float* sh2 = MOD + (size_t)(layer * 3 + mod_index(r)) * 6144 + 3072 + 32 * g;
#pragma unroll
          for (int i = 0; i < 4; ++i) { const u32x4 a = hp[i]; const f32x4 s0 = *(const f32x4*)(sh2 + 8 * i), s1 = *(const f32x4*)(sh2 + 8 * i + 4);
              hv[8 * i] = bflo(a.x) * rs2 + s0.x; hv[8 * i + 1] = bfhi(a.x) * rs2 + s0.y; hv[8 * i + 2] = bflo(a.y) * rs2 + s0.z; hv[8 * i + 3] = bfhi(a.y) * rs2 + s0.w;
              hv[8 * i + 4] = bflo(a.z) * rs2 + s1.x; hv[8 * i + 5] = bfhi(a.z) * rs2 + s1.y; hv[8 * i + 6] = bflo(a.w) * rs2 + s1.z; hv[8 * i + 7] = bfhi(a.w) * rs2 + s1.w; } }
        f32x2 hv2[16], acc2[16];
#pragma unroll
        for (int i = 0; i < 16; ++i) { hv2[i] = (f32x2){hv[2 * i], hv[2 * i + 1]}; acc2[i] = (f32x2){0.f, 0.f}; }
        const int E0 = EID[(size_t)r * 128 + lane], E1 = EID[(size_t)r * 128 + 64 + lane];
        const float G0 = GATE[(size_t)r * 128 + lane], G1 = GATE[(size_t)r * 128 + 64 + lane];
        u32x2 uA[GNJ][3], vA[GNJ][3], uB[GNJ][3], vB[GNJ][3]; float guA[GNJ], gvA[GNJ], guB[GNJ], gvB[GNJ];
#define G_LOAD(UU, VV, GU, GV, e0_) do { _Pragma("unroll") for (int j = 0; j < GNJ; ++j) { const int sl = (e0_) + 2 * j, li = sl & 63; const int Es = sl < 64 ? E0 : E1; const float Gs = sl < 64 ? G0 : G1; \
            const int ea = __builtin_amdgcn_readlane(Es, li), eb = __builtin_amdgcn_readlane(Es, li + 1); const float ga = __builtin_bit_cast(float, __builtin_amdgcn_readlane(__builtin_bit_cast(int, Gs), li)), gb = __builtin_bit_cast(float, __builtin_amdgcn_readlane(__builtin_bit_cast(int, Gs), li + 1)); \
            const int eid = hf ? eb : ea; GU[j] = SCL[eid]; GV[j] = (hf ? gb : ga) * SCL[16384 + eid]; \
            const unsigned roff = (unsigned)eid * 768u + 8u * (unsigned)g; \
            _Pragma("unroll") for (int w = 0; w < 3; ++w) { UU[j][w] = gld8(TU + (roff + 256u * w)); VV[j][w] = gld8(TV + (roff + 256u * w)); } } } while (0)
#define G_USE(UU, VV, GU, GV) do { _Pragma("unroll") for (int j = 0; j < GNJ; ++j) { \
            const f32x32v fu = __builtin_amdgcn_cvt_scalef32_pk32_f32_fp6((u32x6){UU[j][0].x, UU[j][0].y, UU[j][1].x, UU[j][1].y, UU[j][2].x, UU[j][2].y}, 1.0f); \
            f32x2 dA = {0.f, 0.f}, dB = {0.f, 0.f}; _Pragma("unroll") for (int i = 0; i < 16; i += 2) { dA += hv2[i] * (f32x2){fu[2 * i], fu[2 * i + 1]}; dB += hv2[i + 1] * (f32x2){fu[2 * i + 2], fu[2 * i + 3]}; } \
            float d = row16_sum((dA.x + dA.y) + (dB.x + dB.y)); d += __shfl_xor(d, 16); \
            const float coef = GV[j] * gelu_fast(d * GU[j]); \
            const f32x32v fv = __builtin_amdgcn_cvt_scalef32_pk32_f32_fp6((u32x6){VV[j][0].x, VV[j][0].y, VV[j][1].x, VV[j][1].y, VV[j][2].x, VV[j][2].y}, 1.0f); \
            _Pragma("unroll") for (int i = 0; i < 16; ++i) acc2[i] += (f32x2){fv[2 * i], fv[2 * i + 1]} * coef; } } while (0)
        G_LOAD(uA, vA, guA, gvA, s0);
        for (int e0 = s0; e0 < s1; e0 += 4 * GNJ) {
            G_LOAD(uB, vB, guB, gvB, e0 + 2 * GNJ);
            G_USE(uA, vA, guA, gvA);
            if (e0 + 4 * GNJ < s1) G_LOAD(uA, vA, guA, gvA, e0 + 4 * GNJ);
            G_USE(uB, vB, guB, gvB);
        }
#undef G_LOAD
#undef G_USE
        float o[16];
#pragma unroll
        for (int i = 0; i < 16; ++i) { const float lo = (i & 1) ? acc2[i >> 1].y : acc2[i >> 1].x, hi2 = (i & 1) ? acc2[8 + (i >> 1)].y : acc2[8 + (i >> 1)].x; const float mine = hf ? hi2 : lo, send = hf ? lo : hi2; o[i] = mine + __shfl_xor(send, 32); }
        const int col0 = 32 * g + 16 * hf;
        if (tailq) {
            const int wq = gw & 3, wgp = (tid >> 6) >> 2; float* X = smem + (wgp * 4) * 1024;
            __syncthreads();
#pragma unroll
            for (int i = 0; i < 16; i += 4) *(f32x4*)(X + wq * 1024 + col0 + i) = (f32x4){o[i], o[i + 1], o[i + 2], o[i + 3]};
            __syncthreads();
            if (wq != 0) continue;
#pragma unroll
            for (int i = 0; i < 16; i += 4) { const f32x4 a = *(const f32x4*)(X + col0 + i), b2 = *(const f32x4*)(X + 1024 + col0 + i), c2 = *(const f32x4*)(X + 2048 + col0 + i), d2 = *(const f32x4*)(X + 3072 + col0 + i);
                o[i] = (a.x + b2.x) + (c2.x + d2.x); o[i + 1] = (a.y + b2.y) + (c2.y + d2.y); o[i + 2] = (a.z + b2.z) + (c2.z + d2.z); o[i + 3] = (a.w + b2.w) + (c2.w + d2.w); }
        }
        const float* g2 = MOD + (size_t)(layer * 3 + mod_index(r)) * 6144 + 5120 + col0;
        float* xr = XA + (size_t)r * 1024 + col0;
        f32x4 x[4];
#pragma unroll
        for (int q = 0; q < 4; ++q) { const f32x4 gg = *(const f32x4*)(g2 + 4 * q);
            x[q] = *(const f32x4*)(xr + 4 * q); x[q].x += gg.x * o[q * 4 + 0]; x[q].y += gg.y * o[q * 4 + 1]; x[q].z += gg.z * o[q * 4 + 2]; x[q].w += gg.w * o[q * 4 + 3]; }
        float ss = 0.f;
#pragma unroll
        for (int q = 0; q < 4; ++q) ss += x[q].x * x[q].x + x[q].y * x[q].y + x[q].z * x[q].z + x[q].w * x[q].w;
        const float rstd = rsqrtf(wave_sum(ss) * (1.f / 1024.f) + EPS);
        if (DRY) { if (x[0].x == 1.2345e30f) xr[0] = x[1].x + x[2].y + x[3].z; }
        else if (!last) {
            const float* gN = p.norm_g + (layer + 1) * 2 * 1024 + col0; const float* mN = MOD + (size_t)((layer + 1) * 3 + mod_index(r)) * 6144 + col0;
            bf16* hr = (bf16*)(p.ws + WS_H) + (size_t)r * 1024 + col0;
#pragma unroll
            for (int q = 0; q < 4; ++q) { *(f32x4*)(xr + 4 * q) = x[q];
                const f32x4 g4 = *(const f32x4*)(gN + 4 * q), sh = *(const f32x4*)(mN + 4 * q), sc = *(const f32x4*)(mN + 1024 + 4 * q);
                *(u32x2*)(hr + 4 * q) = pk4(x[q] * rstd * g4 * (sc + 1.f) + sh); }
        } else {
#pragma unroll
            for (int q = 0; q < 4; ++q) *(f32x4*)(p.out + (size_t)r * 1024 + col0 + 4 * q) = x[q] * rstd * *(const f32x4*)(p.final_g + col0 + 4 * q);
        }
    }
}


#if defined(PROF_GDRY)
DEVI void ph_gather_dry(const Params& p, int layer) {
    const int* EID = (const int*)(p.ws + WS_EID); float* XA = (float*)(p.ws + WS_XA);
    const unsigned char* TU = p.ws + WS_TAB; const unsigned char* TV = p.ws + WS_TAB + TAB_V;
    const int tid = tidx(), lane = tid & 63, gw = blockIdx.x * NWV + (tid >> 6), NW = gridDim.x * NWV, nrow = layer == DEPTH - 1 ? TX : T;
    for (int r = gw; r < nrow; r += NW) {
        unsigned sum = 0u;
#if PROF_GDRY == 1
        const int g = lane & 31, hf = lane >> 5; const int* er = EID + (size_t)r * 128 + hf;
        for (int e0 = 0; e0 < 128; e0 += 8) {
            u32x2 uu[4][3], vv[4][3];
#pragma unroll
            for (int j = 0; j < 4; ++j) { const int eid = er[e0 + 2 * j];
#pragma unroll
                for (int w = 0; w < 3; ++w) { uu[j][w] = *(const u32x2*)(TU + (size_t)eid * 768 + 8 * g + 256 * w); vv[j][w] = *(const u32x2*)(TV + (size_t)eid * 768 + 8 * g + 256 * w); } }
#pragma unroll
            for (int j = 0; j < 4; ++j)
#pragma unroll
                for (int w = 0; w < 3; ++w) sum += uu[j][w].x ^ uu[j][w].y ^ vv[j][w].x ^ vv[j][w].y;
        }
#elif PROF_GDRY == 2
        const int* er = EID + (size_t)r * 128;
        for (int e0 = 0; e0 < 128; e0 += 8) {
            u32x4 uu[8], vv[8];
#pragma unroll
            for (int j = 0; j < 8; ++j) { const int eid = __builtin_amdgcn_readfirstlane(er[e0 + j]); const int l = lane < 48 ? lane : 47;
                uu[j] = *(const u32x4*)(TU + (size_t)eid * 768 + 16 * l); vv[j] = *(const u32x4*)(TV + (size_t)eid * 768 + 16 * l); }
#pragma unroll
            for (int j = 0; j < 8; ++j) sum += uu[j].x ^ uu[j].y ^ uu[j].z ^ uu[j].w ^ vv[j].x ^ vv[j].y ^ vv[j].z ^ vv[j].w;
        }
#else
        const int t16 = lane & 15, q = lane >> 4; const int* er = EID + (size_t)r * 128 + q;
        for (int e0 = 0; e0 < 128; e0 += 16) {
            u32x4 uu[4][3], vv[4][3];
#pragma unroll
            for (int j = 0; j < 4; ++j) { const int eid = er[e0 + 4 * j];
#pragma unroll
                for (int w = 0; w < 3; ++w) { uu[j][w] = *(const u32x4*)(TU + (size_t)eid * 768 + 16 * t16 + 256 * w); vv[j][w] = *(const u32x4*)(TV + (size_t)eid * 768 + 16 * t16 + 256 * w); } }
#pragma unroll
            for (int j = 0; j < 4; ++j)
#pragma unroll
                for (int w = 0; w < 3; ++w) sum += uu[j][w].x ^ uu[j][w].y ^ uu[j][w].z ^ uu[j][w].w ^ vv[j][w].x ^ vv[j][w].y ^ vv[j][w].z ^ vv[j][w].w;
        }
#endif
        if (sum == 0x12345677u) XA[(size_t)r * 1024 + lane] = 0.f;
    }
}
#endif
DEVI void ph_peer_select(const Params& p, int layer, float* smem) {
    const bf16* QP = (const bf16*)(p.ws + WS_QP); const bf16* SKB = (const bf16*)(p.ws + WT_SK) + (size_t)layer * 16 * 128 * 128;
    int* EID = (int*)(p.ws + WS_EID); float* GATE = (float*)(p.ws + WS_GATE);
    const int tid = tidx(), wid = tid >> 6, lane = tid & 63, fr = lane & 15, fq = lane >> 4;
    const int nblk = layer == DEPTH - 1 ? TX / 128 : T / 128;
    constexpr int LS = 129;
    float* SCL = smem;
    for (int it = blockIdx.x; it < nblk * 8; it += gridDim.x) {
        const int tb = it >> 3, h = it & 7, r0 = tb * 128;
        {
            const int pp = wid & 1, tg = wid >> 1;
            const bf16* Aq = SKB + ((size_t)(h * 2 + pp) * 128) * 128; const bf16* Bq = QP + (size_t)(r0 + tg * 32) * 2048 + h * 256 + pp * 128;
            f32x4 acc[8][2];
#pragma unroll
            for (int a = 0; a < 8; ++a) { acc[a][0] = (f32x4){0.f, 0.f, 0.f, 0.f}; acc[a][1] = (f32x4){0.f, 0.f, 0.f, 0.f}; }
#pragma unroll
            for (int ks = 0; ks < 4; ++ks) {
                bf16x8 bfr[2], afr[8];
#pragma unroll
                for (int n = 0; n < 2; ++n) bfr[n] = *(const bf16x8*)(Bq + (size_t)(n * 16 + fr) * 2048 + ks * 32 + fq * 8);
#pragma unroll
                for (int m = 0; m < 8; ++m) afr[m] = *(const bf16x8*)(Aq + (size_t)(m * 16 + fr) * 128 + ks * 32 + fq * 8);
#pragma unroll
                for (int m = 0; m < 8; ++m)
#pragma unroll
                    for (int n = 0; n < 2; ++n) acc[m][n] = __builtin_amdgcn_mfma_f32_16x16x32_bf16(afr[m], bfr[n], acc[m][n], 0, 0, 0);
            }
            __syncthreads();
#pragma unroll
            for (int m = 0; m < 8; ++m)
#pragma unroll
                for (int n = 0; n < 2; ++n) { float* d = SCL + (size_t)(pp * 128 + tg * 32 + n * 16 + fr) * LS + m * 16 + fq * 4;
                    d[0] = acc[m][n].x; d[1] = acc[m][n].y; d[2] = acc[m][n].z; d[3] = acc[m][n].w; }
        }
        __syncthreads();
        const int tok = tid & 127, pp = (tid >> 7) & 1, kh = tid >> 8;
        float K1[16];
#pragma unroll
        for (int j = 0; j < 16; ++j) K1[j] = -3.0e38f;
        { const float* sp = SCL + (size_t)(pp * 128 + tok) * LS + kh * 64;
#pragma unroll 8
          for (int k = 0; k < 64; ++k) { const float a = sp[k]; const int id = kh * 64 + k; const float key = __uint_as_float((__float_as_uint(a) & ~127u) | (unsigned)(a >= 0.f ? 127 - id : id)); KEY_INSERT(K1, key); } }
        __syncthreads();
        float* XV = smem;
        if (kh == 1) {
#pragma unroll
            for (int j = 0; j < 16; ++j) XV[(pp * 128 + tok) * 17 + j] = K1[j]; }
        __syncthreads();
        if (kh == 0) {
#pragma unroll 4
            for (int j = 0; j < 16; ++j) { const float key = XV[(pp * 128 + tok) * 17 + j]; KEY_INSERT(K1, key); } }
        __syncthreads();
        if (kh == 0 && pp == 1) {
#pragma unroll
            for (int j = 0; j < 16; ++j) XV[tok * 17 + j] = K1[j]; }
        __syncthreads();
        if (kh == 0 && pp == 0) {
            float K2[16];
#pragma unroll
            for (int j = 0; j < 16; ++j) K2[j] = XV[tok * 17 + j];
            int* XI = (int*)smem + 256 * 17 + tok * 33;
#pragma unroll
            for (int j = 0; j < 16; ++j) { const unsigned b1 = __float_as_uint(K1[j]) & 127u, b2 = __float_as_uint(K2[j]) & 127u; XI[j] = K1[j] >= 0.f ? 127 - (int)b1 : (int)b1; XI[16 + j] = K2[j] >= 0.f ? 127 - (int)b2 : (int)b2; }
            float B[16];
#pragma unroll
            for (int j = 0; j < 16; ++j) B[j] = -3.0e38f;
#pragma unroll
            for (int i = 0; i < 16; ++i)
#pragma unroll
                for (int j = 0; j < 16; ++j) if ((i + 1) * (j + 1) <= 16) { const float sc = K1[i] + K2[j]; const int f = i * 16 + j;
                    const float key = __uint_as_float((__float_as_uint(sc) & ~255u) | (unsigned)(sc >= 0.f ? 255 - f : f)); KEY_INSERT(B, key); }
            float e[16], sum = 0.f; int id[16];
#pragma unroll
            for (int j = 0; j < 16; ++j) { e[j] = __expf(B[j] - B[0]); sum += e[j]; const unsigned bb = __float_as_uint(B[j]) & 255u; const int f = B[j] >= 0.f ? 255 - (int)bb : (int)bb; id[j] = XI[f >> 4] * 128 + XI[16 + (f & 15)]; }
            const float inv = 1.f / sum; const size_t o = ((size_t)(r0 + tok) * 8 + h) * 16;
#pragma unroll
            for (int j = 0; j < 16; j += 4) { *(u32x4*)(EID + o + j) = (u32x4){(unsigned)id[j], (unsigned)id[j + 1], (unsigned)id[j + 2], (unsigned)id[j + 3]};
                *(f32x4*)(GATE + o + j) = (f32x4){e[j] * inv, e[j + 1] * inv, e[j + 2] * inv, e[j + 3] * inv}; }
        }
    }
}
DEVI void ph_subkeys(const Params& p) {
    const f32x4* S = (const f32x4*)p.peer_sub_keys; u32x2* O = (u32x2*)(p.ws + WT_SK);
    for (int i = blockIdx.x * NTHR + tidx(); i < 4 * 16 * 128 * 128 / 4; i += gridDim.x * NTHR) { const f32x4 a = S[i]; u32x2 o; o.x = pk2(a.x, a.y); o.y = pk2(a.z, a.w); O[i] = o; }
}

constexpr int SLD = 144;
DEVI s16x4 trr(int addr) { s16x4 r; asm volatile("ds_read_b64_tr_b16 %0, %1" : "=&v"(r) : "v"(addr) : "memory"); return r; }
#define LGKM0() do { asm volatile("s_waitcnt lgkmcnt(0)" ::: "memory"); SBAR(); } while (0)
DEVI bf16x8 pk8(const s16x4 l, const s16x4 h) { return (bf16x8){l[0], l[1], l[2], l[3], h[0], h[1], h[2], h[3]}; }
DEVI bf16x8 cvt8(const f32x4 a, const f32x4 b) { u32x4 w = {pk2(a.x, a.y), pk2(a.z, a.w), pk2(b.x, b.y), pk2(b.z, b.w)}; return *reinterpret_cast<bf16x8*>(&w); }
#define SCAN_DECODE(it_, n_, dir_, hh_, b_) const int n_ = (it_) % NCHUNK, sc_ = (it_) / NCHUNK, dir_ = sc_ & 1, hh_ = (sc_ >> 1) & 7, b_ = sc_ >> 4
DEVI void ph_scan1(const Params& p, int layer, unsigned char* lds) {
    const int jl = layer >> 1, tid = tidx(), wid = tid >> 6, lane = tid & 63, fr = lane & 15, fq = lane >> 4, k = tid & 127, I = tid >> 7;
    const float* LF = (const float*)(p.ws + WS_LF); const bf16 *VS = (const bf16*)(p.ws + WS_VS), *KR = (const bf16*)(p.ws + WS_KR);
    bf16* UT = (bf16*)(p.ws + WS_UT); float* DEC = (float*)(p.ws + WS_DEC);
    bf16* KH = (bf16*)lds; bf16* VV = KH + 64 * SLD; float* TOT = (float*)(VV + 64 * SLD);
    const int trb = (int)(uintptr_t)lds + (((lane >> 2) & 3) * SLD + (lane & 3) * 4) * 2;
    const int NIT = 32 * NCHUNK, G = gridDim.x;
    float rlf[16]; unsigned short rkr[16], rvs[16];
#define S1_LOAD(itx) do { SCAN_DECODE(itx, n2, dir2, hh2, b2); \
        if (hh2 < 4) { _Pragma("unroll") for (int i = 0; i < 16; ++i) rlf[i] = LF[((size_t)dir2 * T + scan_row(b2, dir2, n2 * 64 + I * 16 + i)) * 512 + hh2 * 128 + k]; } \
        else { _Pragma("unroll") for (int i = 0; i < 16; ++i) rkr[i] = KR[(size_t)scan_row(b2, dir2, n2 * 64 + I * 16 + i) * 512 + (hh2 - 4) * 128 + k]; } \
        _Pragma("unroll") for (int i = 0; i < 16; ++i) rvs[i] = VS[(size_t)scan_row(b2, dir2, n2 * 64 + I * 16 + i) * 1024 + hh2 * 128 + k]; } while (0)
    if ((int)blockIdx.x < NIT) S1_LOAD((int)blockIdx.x);
    for (int it = blockIdx.x; it < NIT; it += G) {
        SCAN_DECODE(it, n, dir, hh, b); (void)n; (void)b;
        const float lg = hh >= 4 ? -__expf(p.ret_log_decay[(jl * 2 + dir) * 4 + (hh - 4)]) : 0.f;
        float lc[16], kk[16]; float run = 0.f;
#pragma unroll
        for (int i = 0; i < 16; ++i) { const float lf = hh < 4 ? rlf[i] : lg; const float kv = hh < 4 ? 1.f - __expf(lf) : bf2f(rkr[i]); run += lf; lc[i] = run; kk[i] = kv; }
        TOT[I * 128 + k] = run;
        __syncthreads();
        float after = 0.f;
#pragma unroll
        for (int J = 0; J < 4; ++J) after += (J > I) ? TOT[J * 128 + k] : 0.f;
        if (I == 0) DEC[(size_t)it * 128 + k] = __expf(after + run);
        { const float ea = __expf(after + run);
#pragma unroll
          for (int i = 0; i < 16; ++i) { KH[(I * 16 + i) * SLD + k] = f2bf_hw(kk[i] * __expf(-lc[i]) * ea); VV[(I * 16 + i) * SLD + k] = rvs[i]; } }
        if (it + G < NIT) S1_LOAD(it + G);
        __syncthreads();
        f32x4 acc[8];
#pragma unroll
        for (int a = 0; a < 8; ++a) acc[a] = (f32x4){0.f, 0.f, 0.f, 0.f};
#pragma unroll
        for (int t = 0; t < 2; ++t) {
            const int rb = trb + ((32 * t + 8 * fq) * SLD) * 2;
            const s16x4 al = trr(rb + (16 * wid) * 2), ah = trr(rb + (4 * SLD + 16 * wid) * 2);
            s16x4 bl[8], bh[8];
#pragma unroll
            for (int nt = 0; nt < 8; ++nt) { bl[nt] = trr(rb + (64 * SLD + 16 * nt) * 2); bh[nt] = trr(rb + (68 * SLD + 16 * nt) * 2); }
            LGKM0();
            const bf16x8 A = pk8(al, ah);
#pragma unroll
            for (int nt = 0; nt < 8; ++nt) acc[nt] = __builtin_amdgcn_mfma_f32_16x16x32_bf16(A, pk8(bl[nt], bh[nt]), acc[nt], 0, 0, 0);
        }
        bf16* U = UT + (size_t)it * 16384 + 16 * wid + fq * 4;
#pragma unroll
        for (int nt = 0; nt < 8; ++nt) *(u32x2*)(U + (size_t)(nt * 16 + fr) * 128) = pk4(acc[nt]);
    }
#undef S1_LOAD
}
DEVI void ph_scan2(const Params& p) {
    u32x4* UT = (u32x4*)(p.ws + WS_UT); const float* DEC = (const float*)(p.ws + WS_DEC); const int tid = tidx();
    for (int it = blockIdx.x; it < 32 * 4; it += gridDim.x) {
        const int sc = it >> 2, e8 = (it & 3) * NTHR + tid, k8 = (e8 & 15) * 8; float st[8];
#pragma unroll
        for (int i = 0; i < 8; ++i) st[i] = 0.f;
        u32x4* u = UT + (size_t)sc * NCHUNK * 2048 + e8; const float* dp = DEC + (size_t)sc * NCHUNK * 128 + k8;
        for (int n0 = 0; n0 < NCHUNK; n0 += 6) {
            u32x4 uu[6]; f32x4 d0[6], d1[6];
#pragma unroll
            for (int j = 0; j < 6; ++j) { uu[j] = u[(size_t)(n0 + j) * 2048]; d0[j] = *(const f32x4*)(dp + (size_t)(n0 + j) * 128); d1[j] = *(const f32x4*)(dp + (size_t)(n0 + j) * 128 + 4); }
#pragma unroll
            for (int j = 0; j < 6; ++j) {
                u32x4 o; o.x = pk2(st[0], st[1]); o.y = pk2(st[2], st[3]); o.z = pk2(st[4], st[5]); o.w = pk2(st[6], st[7]); u[(size_t)(n0 + j) * 2048] = o;
                st[0] = d0[j].x * st[0] + bflo(uu[j].x); st[1] = d0[j].y * st[1] + bfhi(uu[j].x); st[2] = d0[j].z * st[2] + bflo(uu[j].y); st[3] = d0[j].w * st[3] + bfhi(uu[j].y);
                st[4] = d1[j].x * st[4] + bflo(uu[j].z); st[5] = d1[j].y * st[5] + bfhi(uu[j].z); st[6] = d1[j].z * st[6] + bflo(uu[j].w); st[7] = d1[j].w * st[7] + bfhi(uu[j].w);
            }
        }
    }
}
DEVI void ph_scan3(const Params& p, int layer, unsigned char* lds) {
    const int jl = layer >> 1, tid = tidx(), wid = tid >> 6, lane = tid & 63, fr = lane & 15, fq = lane >> 4, k = tid & 127, I = tid >> 7;
    const float* LF = (const float*)(p.ws + WS_LF); const bf16 *VS = (const bf16*)(p.ws + WS_VS), *KR = (const bf16*)(p.ws + WS_KR), *QS = (const bf16*)(p.ws + WS_QS);
    const bf16* UT = (const bf16*)(p.ws + WS_UT); bf16* OFB = (bf16*)(p.ws + WS_OFB);
    bf16* QH = (bf16*)lds; bf16* QT = QH + 64 * SLD; bf16* VV = QT + 64 * SLD; bf16* KT = VV + 64 * SLD; float* TOT = (float*)(KT + 160 * SLD);
    const int trv = (int)(uintptr_t)VV + (((lane >> 2) & 3) * SLD + (lane & 3) * 4 + 16 * wid) * 2 + (4 * fq * SLD) * 2;
    const int NIT = 32 * NCHUNK, G = gridDim.x;
    float rlf[16]; unsigned short rkr[16], rvs[16], rqs[16];
#define S3_LOAD(itx) do { SCAN_DECODE(itx, n2, dir2, hh2, b2); \
        if (hh2 < 4) { _Pragma("unroll") for (int i = 0; i < 16; ++i) rlf[i] = LF[((size_t)dir2 * T + scan_row(b2, dir2, n2 * 64 + I * 16 + i)) * 512 + hh2 * 128 + k]; } \
        else { _Pragma("unroll") for (int i = 0; i < 16; ++i) rkr[i] = KR[(size_t)scan_row(b2, dir2, n2 * 64 + I * 16 + i) * 512 + (hh2 - 4) * 128 + k]; } \
        _Pragma("unroll") for (int i = 0; i < 16; ++i) { const int row = scan_row(b2, dir2, n2 * 64 + I * 16 + i); rvs[i] = VS[(size_t)row * 1024 + hh2 * 128 + k]; rqs[i] = QS[(size_t)row * 1024 + hh2 * 128 + k]; } } while (0)
    if ((int)blockIdx.x < NIT) S3_LOAD((int)blockIdx.x);
    for (int it = blockIdx.x; it < NIT; it += G) {
        SCAN_DECODE(it, n, dir, hh, b);
        const float lg = hh >= 4 ? -__expf(p.ret_log_decay[(jl * 2 + dir) * 4 + (hh - 4)]) : 0.f;
        bf16x8 stv[4];
        { const bf16* ST = UT + (size_t)it * 16384 + (size_t)(16 * wid + fr) * 128 + fq * 8;
#pragma unroll
          for (int ks = 0; ks < 4; ++ks) stv[ks] = *(const bf16x8*)(ST + ks * 32); }
        float lc[16], kk[16]; float run = 0.f;
#pragma unroll
        for (int i = 0; i < 16; ++i) { const float lf = hh < 4 ? rlf[i] : lg; const float kv = hh < 4 ? 1.f - __expf(lf) : bf2f(rkr[i]); run += lf; lc[i] = run; kk[i] = kv; }
        TOT[I * 128 + k] = run;
        __syncthreads();
        float ref = 0.f;
#pragma unroll
        for (int J = 0; J < 4; ++J) ref += (J < I) ? TOT[J * 128 + k] : 0.f;
        { const float er = __expf(ref);
#pragma unroll
          for (int i = 0; i < 16; ++i) { const int c = I * 16 + i; const float e = __expf(lc[i]), qt = bf2f(rqs[i]) * e;
              QH[c * SLD + k] = f2bf_hw(qt * er); QT[c * SLD + k] = f2bf_hw(qt); VV[c * SLD + k] = rvs[i]; kk[i] *= __builtin_amdgcn_rcpf(e); } }
        { float delta = 0.f;
#pragma unroll
          for (int I2 = 0; I2 < 4; ++I2) { if (I2 >= I) { bf16* kt = KT + ((I2 * (I2 + 1) / 2 + I) * 16) * SLD + k; const float ed = __expf(delta);
#pragma unroll
                  for (int i = 0; i < 16; ++i) kt[i * SLD] = f2bf_hw(kk[i] * ed);
                  delta += TOT[I2 * 128 + k]; } } }
        if (it + G < NIT) S3_LOAD(it + G);
        __syncthreads();
        f32x4 acc[4];
#pragma unroll
        for (int a = 0; a < 4; ++a) acc[a] = (f32x4){0.f, 0.f, 0.f, 0.f};
#pragma unroll
        for (int ks = 0; ks < 4; ++ks) { const bf16x8 A = stv[ks];
#pragma unroll
            for (int c4 = 0; c4 < 4; ++c4) acc[c4] = __builtin_amdgcn_mfma_f32_16x16x32_bf16(A, *(const bf16x8*)(QH + (c4 * 16 + fr) * SLD + ks * 32 + fq * 8), acc[c4], 0, 0, 0); }
#pragma unroll
        for (int I2 = 0; I2 < 4; ++I2) {
            f32x4 at[4];
#pragma unroll
            for (int J = 0; J < 4; ++J) { at[J] = (f32x4){0.f, 0.f, 0.f, 0.f};
                if (J <= I2) {
#pragma unroll
                    for (int ks = 0; ks < 4; ++ks) at[J] = __builtin_amdgcn_mfma_f32_16x16x32_bf16(*(const bf16x8*)(KT + ((I2 * (I2 + 1) / 2 + J) * 16 + fr) * SLD + ks * 32 + fq * 8),
                                                                                                   *(const bf16x8*)(QT + (I2 * 16 + fr) * SLD + ks * 32 + fq * 8), at[J], 0, 0, 0);
                    if (J == I2) { if (fq * 4 + 0 > fr) at[J].x = 0.f; if (fq * 4 + 1 > fr) at[J].y = 0.f; if (fq * 4 + 2 > fr) at[J].z = 0.f; if (fq * 4 + 3 > fr) at[J].w = 0.f; }
                } }
#pragma unroll
            for (int t = 0; t < 2; ++t) if (2 * t <= I2) {
                const s16x4 vl = trr(trv + ((2 * t) * 16 * SLD) * 2), vh = trr(trv + ((2 * t + 1) * 16 * SLD) * 2);
                LGKM0();
                acc[I2] = __builtin_amdgcn_mfma_f32_16x16x32_bf16(pk8(vl, vh), cvt8(at[2 * t], at[2 * t + 1]), acc[I2], 0, 0, 0);
            }
        }
#pragma unroll
        for (int c4 = 0; c4 < 4; ++c4) { const int row = scan_row(b, dir, n * 64 + c4 * 16 + fr);
            *(u32x2*)(OFB + ((size_t)dir * T + row) * 1024 + hh * 128 + 16 * wid + fq * 4) = pk4(acc[c4]); }
    }
#undef S3_LOAD
}

constexpr size_t WT_GW = WS_WT + 54 * MiB;
DEVI void ph_gmlp(const Params& p, int layer, unsigned char* lds) {
    const int j = layer >> 1, tid = tidx(), wid = tid >> 6, lane = tid & 63, fr = lane & 15, fq = lane >> 4;
    const bf16 *UB = (const bf16*)(p.ws + WS_UB), *VG = (const bf16*)(p.ws + WS_VG); bf16* OX = (bf16*)(p.ws + WS_OX);
    bf16* VN = (bf16*)lds;
    const int trb = (int)(uintptr_t)lds + (((lane >> 2) & 3) * SLD + (lane & 3) * 4 + 16 * wid) * 2 + (8 * fq * SLD) * 2;
    const int nfull = ((T / 128) * 4 / (int)gridDim.x) * (int)gridDim.x;
    for (int k = 0;; ++k) {
        int it = k * (int)gridDim.x + (int)blockIdx.x;
        if (it >= nfull) { const int rem = (int)blockIdx.x - 16; if (k * (int)gridDim.x != nfull || rem < 0 || nfull + rem >= (T / 128) * 4) break; it = nfull + rem; }
        const int ch = it >> 2, g = it & 3, r0 = ch * 128;
        __syncthreads();
#pragma unroll 4
        for (int rr = 0; rr < 16; ++rr) {
            const int row = wid * 16 + rr; const u32x4 a = *(const u32x4*)(VG + (size_t)(r0 + row) * 512 + lane * 8);
            float x[8] = {bflo(a.x), bfhi(a.x), bflo(a.y), bfhi(a.y), bflo(a.z), bfhi(a.z), bflo(a.w), bfhi(a.w)};
            float sm = 0.f;
#pragma unroll
            for (int i = 0; i < 8; ++i) sm += x[i];
            const float mean = wave_sum(sm) * (1.f / 512.f); float qq = 0.f;
#pragma unroll
            for (int i = 0; i < 8; ++i) { x[i] -= mean; qq += x[i] * x[i]; }
            const float rstd = rsqrtf(wave_sum(qq) * (1.f / 512.f) + EPS);
            if ((lane >> 4) == g) { const float* gn = p.gmlp_v_gain + j * 512 + lane * 8; const f32x4 g0 = *(const f32x4*)gn, g1 = *(const f32x4*)(gn + 4);
                u32x4 o; o.x = pk2(x[0] * rstd * g0.x, x[1] * rstd * g0.y); o.y = pk2(x[2] * rstd * g0.z, x[3] * rstd * g0.w); o.z = pk2(x[4] * rstd * g1.x, x[5] * rstd * g1.y); o.w = pk2(x[6] * rstd * g1.z, x[7] * rstd * g1.w);
                *(u32x4*)(VN + row * SLD + (lane & 15) * 8) = o; }
        }
        __syncthreads();
        const bf16* WB = (const bf16*)(p.ws + WT_GW) + (size_t)(j * 4 + g) * 128 * 128;
        f32x4 acc[8];
#pragma unroll
        for (int a = 0; a < 8; ++a) acc[a] = (f32x4){0.f, 0.f, 0.f, 0.f};
#pragma unroll
        for (int ks = 0; ks < 4; ++ks) {
            bf16x8 bw[8];
#pragma unroll
            for (int nt = 0; nt < 8; ++nt) bw[nt] = *(const bf16x8*)(WB + (size_t)(nt * 16 + fr) * 128 + ks * 32 + fq * 8);
            const s16x4 al = trr(trb + (32 * ks * SLD) * 2), ah = trr(trb + ((32 * ks + 4) * SLD) * 2);
            LGKM0();
            const bf16x8 A = pk8(al, ah);
#pragma unroll
            for (int nt = 0; nt < 8; ++nt) acc[nt] = __builtin_amdgcn_mfma_f32_16x16x32_bf16(A, bw[nt], acc[nt], 0, 0, 0);
        }
#pragma unroll
        for (int nt = 0; nt < 8; ++nt) { const int pi = nt * 16 + fr; const float bsv = p.gmlp_bs[(j * 4 + g) * 128 + pi];
            const size_t o = (size_t)(r0 + pi) * 1024 + g * 128 + 16 * wid + fq * 4; const u32x2 uu = *(const u32x2*)(UB + (size_t)(r0 + pi) * 512 + g * 128 + 16 * wid + fq * 4);
            u32x2 w; w.x = pk2(bflo(uu.x) * (acc[nt].x + bsv), bfhi(uu.x) * (acc[nt].y + bsv)); w.y = pk2(bflo(uu.y) * (acc[nt].z + bsv), bfhi(uu.y) * (acc[nt].w + bsv));
            *(u32x2*)(OX + o) = w; }
    }
}
DEVI void ph_gmlp_weights(const Params& p) {
    const f32x4* S = (const f32x4*)p.gmlp_ws; u32x2* O = (u32x2*)(p.ws + WT_GW);
    for (int i = blockIdx.x * NTHR + tidx(); i < 2 * 4 * 128 * 128 / 4; i += gridDim.x * NTHR) { const f32x4 a = S[i]; u32x2 o; o.x = pk2(a.x, a.y); o.y = pk2(a.z, a.w); O[i] = o; }
}

namespace pg8 {
#define PG8_LAS __attribute__((address_space(3)))
typedef unsigned short bf16_t;
typedef short bf16x8 __attribute__((ext_vector_type(8)));
typedef float f32x4 __attribute__((ext_vector_type(4)));
typedef unsigned u32x4 __attribute__((ext_vector_type(4)));
constexpr int BM = 256, BK = 64, HALF = 128, HTB = HALF * BK * 2  , STAGE_BYTES = 8 * HTB, NXCD = 8, WGM = 8;

__host__ __device__ __forceinline__ int lds_byte(int r, int c) { const int st = (r >> 4) * 2 + (c >> 5), rr = r & 15, cc = c & 31, ob = rr * 64 + cc * 2; return st * 1024 + (ob ^ (((ob >> 9) & 1) << 5)); }
__host__ __device__ __forceinline__ void stage_rc(int b, int& R, int& C) { const int st = b / 1024, sb = b % 1024, swz = sb ^ (((sb >> 9) & 1) << 5); R = (st >> 1) * 16 + swz / 64; C = (st & 1) * 32 + (swz % 64) / 2; }
__host__ __device__ __forceinline__ int perm32(int rho) { const int n = rho >> 4, i = rho & 15; return 8 * (i >> 2) + 4 * n + (i & 3); }

struct Unit { int pm, pn; };
struct Gemm { const bf16_t* A; const bf16_t* Bt; int M, N, K; };

struct StaticOrder {
    int nM, nN, nwg, G, c;
    __host__ __device__ void init(int M, int N, int G_, int c_) { nM = M / BM; nN = N / BM; nwg = nM * nN; G = G_; c = c_; }
    __host__ __device__ bool next(int i, Unit& u) const {
        const long L = (long)i * G + c; if (L >= nwg) return false;
        int wgid = (int)L; { const int q = nwg / NXCD, r = nwg % NXCD, xcd = wgid % NXCD, off = wgid / NXCD; wgid = (xcd < r ? xcd * (q + 1) : r * (q + 1) + (xcd - r) * q) + off; }
        const int nig = WGM * nN, gid = wgid / nig, fm = gid * WGM, gsz = (nM - fm) < WGM ? (nM - fm) : WGM;
        u.pm = fm + ((wgid % nig) % gsz); u.pn = (wgid % nig) / gsz; return true;
    }
    __device__ __forceinline__ void a_ready(const Unit&) const {}
    __device__ __forceinline__ void done(const Unit&) const {}
};

template <class Epi, class Sched, bool ALIGN_EPI = false, bool SP2 = false>
__device__ __forceinline__ void gemm_phase(PG8_LAS unsigned char* lds, const Gemm g, const Sched& S, const Epi& E) {
    const int tid = tidx(), wid = __builtin_amdgcn_readfirstlane(tid >> 6), lane = tid & 63, wr = wid >> 2, wc = wid & 3, fr = lane & 15, fq = lane >> 4;
    const int K = g.K, nt = K / BK;
    unsigned voffA[2], voffB[2];
#pragma unroll
    for (int i = 0; i < 2; ++i) { int R, C; stage_rc(tid * 16 + i * 8192, R, C); const int Rb = Epi::PERM ? ((R & ~31) + perm32(R & 31)) : R;
        voffA[i] = (unsigned)(R * K + C) * 2u; voffB[i] = (unsigned)(Rb * K + C) * 2u; }
    const size_t kstep = (size_t)(BK * 2);
    const size_t hstep = (size_t)HALF * K * 2;
    const size_t tstep = 2 * hstep;
    const unsigned ldsw = (unsigned)wid * 1024u;
    const int aoff = lds_byte(wr * 64 + fr, fq * 8), boff = lds_byte(wc * 32 + fr, fq * 8);
#define PG8_SA(b, h) (((b) * 2 + (h)) * HTB)
#define PG8_SB(b, h) ((4 + (b) * 2 + (h)) * HTB)
#define PG8_STAGE(bufoff, gbase, voff) do { _Pragma("unroll") for (int _i = 0; _i < 2; ++_i) \
        __builtin_amdgcn_global_load_lds((const unsigned*)((const char*)(gbase) + (voff)[_i]), (PG8_LAS unsigned*)(lds + (bufoff) + ldsw + _i * 8192), 16, 0, 0); } while (0)
#define PG8_LDA(dst, b, h) do { _Pragma("unroll") for (int m = 0; m < 4; ++m) _Pragma("unroll") for (int k = 0; k < 2; ++k) dst[m][k] = *(const PG8_LAS bf16x8*)(lds + PG8_SA(b, h) + aoff + m * 2048 + k * 1024); } while (0)
#define PG8_LDB(dst, b, h) do { _Pragma("unroll") for (int n = 0; n < 2; ++n) _Pragma("unroll") for (int k = 0; k < 2; ++k) dst[n][k] = *(const PG8_LAS bf16x8*)(lds + PG8_SB(b, h) + boff + n * 2048 + k * 1024); } while (0)
#define PG8_MMA(ai, bj, At, Bt) do { __builtin_amdgcn_s_setprio(1); _Pragma("unroll") for (int m = 0; m < 4; ++m) _Pragma("unroll") for (int n = 0; n < 2; ++n) _Pragma("unroll") for (int k = 0; k < 2; ++k) \
        acc[ai][bj][m][n] = __builtin_amdgcn_mfma_f32_16x16x32_bf16(Bt[n][k], At[m][k], acc[ai][bj][m][n], 0, 0, 0); __builtin_amdgcn_s_setprio(0); } while (0)
#define PG8_WAIT_V(n) asm volatile("s_waitcnt vmcnt(" #n ")" ::: "memory")
#define PG8_WAIT_L(n) asm volatile("s_waitcnt lgkmcnt(" #n ")" ::: "memory")
#define PG8_BAR __builtin_amdgcn_s_barrier()
#define PG8_SCHED __builtin_amdgcn_sched_barrier(0)
    Unit cur, nxt; int ui = 0;
    if (!S.next(0, cur)) return;
    f32x4 acc[2][2][4][2];
#pragma unroll
    for (int a = 0; a < 2; ++a)
#pragma unroll
        for (int b = 0; b < 2; ++b)
#pragma unroll
            for (int m = 0; m < 4; ++m)
#pragma unroll
                for (int n = 0; n < 2; ++n) acc[a][b][m][n] = (f32x4){0.f, 0.f, 0.f, 0.f};
    bf16x8 At[4][2], B0[2][2], B1[2][2];
    const char* cA = (const char*)g.A + (size_t)cur.pm * tstep; const char* cB = (const char*)g.Bt + (size_t)cur.pn * tstep;
    S.a_ready(cur);
    if constexpr (SP2) {
        PG8_STAGE(PG8_SB(0, 0), cB, voffB); PG8_STAGE(PG8_SB(0, 1), cB + hstep, voffB); PG8_STAGE(PG8_SA(0, 0), cA, voffA); PG8_STAGE(PG8_SA(0, 1), cA + hstep, voffA);
        if (wr == 1) PG8_BAR;
        PG8_WAIT_V(2); PG8_BAR;
        PG8_STAGE(PG8_SB(1, 0), cB + kstep, voffB); PG8_STAGE(PG8_SA(1, 0), cA + kstep, voffA); PG8_STAGE(PG8_SB(1, 1), cB + hstep + kstep, voffB);
        PG8_WAIT_V(6); PG8_BAR;
    } else {
        PG8_STAGE(PG8_SB(0, 0), cB, voffB); PG8_STAGE(PG8_SA(0, 0), cA, voffA); PG8_STAGE(PG8_SB(0, 1), cB + hstep, voffB); PG8_STAGE(PG8_SA(0, 1), cA + hstep, voffA);
        if (wr == 1) PG8_BAR;
        PG8_WAIT_V(4); PG8_BAR;
        PG8_STAGE(PG8_SB(1, 0), cB + kstep, voffB); PG8_STAGE(PG8_SA(1, 0), cA + kstep, voffA); PG8_STAGE(PG8_SB(1, 1), cB + hstep + kstep, voffB);
        PG8_WAIT_V(6); PG8_BAR;
    }
    for (;;) {
        const bool has_next = S.next(ui + 1, nxt);
        const char* nA = has_next ? (const char*)g.A + (size_t)nxt.pm * tstep : cA; const char* nB = has_next ? (const char*)g.Bt + (size_t)nxt.pn * tstep : cB;
        for (int t = 0; t < nt; t += 2) {
            const bool last = (t == nt - 2);
            const char* a1 = cA + (size_t)(t + 1) * kstep;
            const char* a2 = last ? nA : cA + (size_t)(t + 2) * kstep; const char* b2 = last ? nB : cB + (size_t)(t + 2) * kstep;
            const char* a3 = a2 + kstep; const char* b3 = b2 + kstep;
            if (last && has_next) S.a_ready(nxt);
            if constexpr (SP2) {
            PG8_LDB(B0, 0, 0); PG8_LDB(B1, 0, 1); PG8_SCHED; PG8_LDA(At, 0, 0); PG8_STAGE(PG8_SA(1, 1), a1 + hstep, voffA);
            PG8_WAIT_V(8); PG8_WAIT_L(0); PG8_BAR; PG8_MMA(0, 0, At, B0); PG8_MMA(0, 1, At, B1); PG8_BAR; PG8_SCHED;
            PG8_LDA(At, 0, 1); PG8_STAGE(PG8_SB(0, 0), b2, voffB); PG8_STAGE(PG8_SB(0, 1), b2 + hstep, voffB); PG8_STAGE(PG8_SA(0, 0), a2, voffA);
            PG8_WAIT_V(8); PG8_WAIT_L(0); PG8_BAR; PG8_MMA(1, 0, At, B0); PG8_MMA(1, 1, At, B1); PG8_BAR; PG8_SCHED;
            PG8_LDB(B0, 1, 0); PG8_LDB(B1, 1, 1); PG8_SCHED; PG8_LDA(At, 1, 0); PG8_STAGE(PG8_SA(0, 1), a2 + hstep, voffA);
            PG8_WAIT_V(8); PG8_WAIT_L(0); PG8_BAR; PG8_MMA(0, 0, At, B0); PG8_MMA(0, 1, At, B1); PG8_BAR; PG8_SCHED;
            PG8_LDA(At, 1, 1); PG8_STAGE(PG8_SB(1, 0), b3, voffB); PG8_STAGE(PG8_SB(1, 1), b3 + hstep, voffB); PG8_STAGE(PG8_SA(1, 0), a3, voffA);
            PG8_WAIT_V(8); PG8_WAIT_L(0); PG8_BAR; PG8_MMA(1, 0, At, B0); PG8_MMA(1, 1, At, B1); PG8_BAR; PG8_SCHED;
            } else {
            PG8_LDB(B0, 0, 0); PG8_SCHED; PG8_LDA(At, 0, 0); PG8_STAGE(PG8_SA(1, 1), a1 + hstep, voffA);
            PG8_WAIT_L(8); PG8_BAR; PG8_WAIT_L(0); PG8_MMA(0, 0, At, B0); PG8_BAR; PG8_SCHED;
            PG8_LDB(B1, 0, 1); PG8_STAGE(PG8_SB(0, 0), b2, voffB);
            PG8_BAR; PG8_WAIT_L(0); PG8_MMA(0, 1, At, B1); PG8_BAR;
            PG8_LDA(At, 0, 1); PG8_STAGE(PG8_SA(0, 0), a2, voffA);
            PG8_BAR; PG8_WAIT_L(0); PG8_MMA(1, 0, At, B0); PG8_BAR; PG8_SCHED;
            PG8_STAGE(PG8_SB(0, 1), b2 + hstep, voffB);
            PG8_WAIT_V(6); PG8_BAR; PG8_MMA(1, 1, At, B1); PG8_BAR;
            PG8_LDB(B0, 1, 0); PG8_SCHED; PG8_LDA(At, 1, 0); PG8_STAGE(PG8_SA(0, 1), a2 + hstep, voffA);
            PG8_WAIT_L(8); PG8_BAR; PG8_WAIT_L(0); PG8_MMA(0, 0, At, B0); PG8_BAR; PG8_SCHED;
            PG8_LDB(B1, 1, 1); PG8_STAGE(PG8_SB(1, 0), b3, voffB);
            PG8_BAR; PG8_WAIT_L(0); PG8_MMA(0, 1, At, B1); PG8_BAR;
            PG8_LDA(At, 1, 1); PG8_STAGE(PG8_SA(1, 0), a3, voffA);
            PG8_BAR; PG8_WAIT_L(0); PG8_MMA(1, 0, At, B0); PG8_BAR; PG8_SCHED;
            PG8_STAGE(PG8_SB(1, 1), b3 + hstep, voffB);
            PG8_WAIT_V(6); PG8_BAR; PG8_MMA(1, 1, At, B1); PG8_BAR;
            }
        }
        if constexpr (ALIGN_EPI) { if (wr == 0) PG8_BAR; }
        if constexpr (!Epi::AFTER_DRAIN) { E(acc, cur, wr, wc, fr, fq); S.done(cur); }
        if (!has_next) break;
#pragma unroll
        for (int a = 0; a < 2; ++a)
#pragma unroll
            for (int b = 0; b < 2; ++b)
#pragma unroll
                for (int m = 0; m < 4; ++m)
#pragma unroll
                    for (int n = 0; n < 2; ++n) acc[a][b][m][n] = (f32x4){0.f, 0.f, 0.f, 0.f};
        cur = nxt; cA = nA; cB = nB; ++ui;
        if constexpr (ALIGN_EPI) { if (wr == 1) PG8_BAR; }
    }
    PG8_WAIT_V(0);
    if constexpr (!ALIGN_EPI) { if (wr == 0) PG8_BAR; }
    PG8_BAR;
    if constexpr (Epi::AFTER_DRAIN) { E.fused(acc, cur, wr, wc, fr, fq, lds, wid, lane); S.done(cur); }
#undef PG8_SA
#undef PG8_SB
#undef PG8_STAGE
#undef PG8_LDA
#undef PG8_LDB
#undef PG8_MMA
#undef PG8_WAIT_V
#undef PG8_WAIT_L
#undef PG8_BAR
#undef PG8_SCHED
}
}

namespace pg8 {
DEVI void rope_pair(f32x4& x1, f32x4& x2, float pos, const float (&inv)[4]) {
    const float a0 = pos * inv[0], a1 = pos * inv[1], a2 = pos * inv[2], a3 = pos * inv[3];
    const float c0 = __cosf(a0), s0 = __sinf(a0), c1 = __cosf(a1), s1 = __sinf(a1), c2 = __cosf(a2), s2 = __sinf(a2), c3 = __cosf(a3), s3 = __sinf(a3);
    const f32x4 y1 = {x1.x * c0 - x2.x * s0, x1.y * c1 - x2.y * s1, x1.z * c2 - x2.z * s2, x1.w * c3 - x2.w * s3};
    const f32x4 y2 = {x1.x * s0 + x2.x * c0, x1.y * s1 + x2.y * c1, x1.z * s2 + x2.z * c2, x1.w * s3 + x2.w * c3};
    x1 = y1; x2 = y2;
}
DEVI f32x4 gelu4(f32x4 v) { return (f32x4){gelu_(v.x), gelu_(v.y), gelu_(v.z), gelu_(v.w)}; }
DEVI f32x4 silu4(f32x4 v) { return (f32x4){silu_(v.x), silu_(v.y), silu_(v.z), silu_(v.w)}; }
struct EpiEvenP {
    static constexpr bool PERM = false, AFTER_DRAIN = false; unsigned char* ws;
    DEVI void operator()(const f32x4 (&acc)[2][2][4][2], const Unit& u, int wr, int wc, int fr, int fq) const {
        const int blk = u.pn >> 1;
        ::bf16* dst = (::bf16*)(ws + (blk == 0 ? WS_KB : blk == 1 ? WS_VB : blk == 2 ? WS_UB : blk == 3 ? WS_VG : WS_QB));
        float inv[4];
#pragma unroll
        for (int j = 0; j < 4; ++j) inv[j] = exp2f(-(float)(4 * fq + j) * (13.287712379549449f / 16.f));
#pragma unroll
        for (int bj = 0; bj < 2; ++bj) { const int cc0 = ((u.pn & 1) * 256 + 128 * bj + 32 * wc) + 4 * fq;
#pragma unroll
            for (int ai = 0; ai < 2; ++ai)
#pragma unroll
                for (int m = 0; m < 4; ++m) { const int r = u.pm * BM + 128 * ai + 64 * wr + 16 * m + fr; f32x4 x1 = acc[ai][bj][m][0], x2 = acc[ai][bj][m][1];
                    if (blk == 0 || blk == 4) { const int t = r & (SEQ - 1); rope_pair(x1, x2, (float)((wc & 1) ? (t & 63) : (t >> 6)), inv);
                        if (blk == 4) { x1 = x1 * (DIFF_SCALE * LOG2E); x2 = x2 * (DIFF_SCALE * LOG2E); } }
                    else if (blk >= 2) { x1 = gelu4(x1); x2 = gelu4(x2); }
                    *(u32x2*)(dst + (size_t)r * 512 + cc0) = pk4(x1); *(u32x2*)(dst + (size_t)r * 512 + cc0 + 16) = pk4(x2); } }
    }
};
struct EpiOddP {
    static constexpr bool PERM = false, AFTER_DRAIN = false; unsigned char* ws; const float* LB;
    DEVI void operator()(const f32x4 (&acc)[2][2][4][2], const Unit& u, int wr, int wc, int fr, int fq) const {
        const int blk = u.pn >> 1;
        float inv[4];
#pragma unroll
        for (int j = 0; j < 4; ++j) inv[j] = exp2f(-(float)((wc & 1) * 16 + 4 * fq + j) * (13.287712379549449f / 32.f));
#pragma unroll
        for (int bj = 0; bj < 2; ++bj) { const int cb = (u.pn & 1) * 256 + 128 * bj;
            const int cc0 = cb + 32 * wc + 4 * fq;
            const int lc0 = cb + (wc >> 1) * 64 + (wc & 1) * 16 + 4 * fq;
#pragma unroll
            for (int ai = 0; ai < 2; ++ai)
#pragma unroll
                for (int m = 0; m < 4; ++m) { const int r = u.pm * BM + 128 * ai + 64 * wr + 16 * m + fr; f32x4 x1 = acc[ai][bj][m][0], x2 = acc[ai][bj][m][1];
                    if (blk <= 1) { float* LF = (float*)(ws + WS_LF) + ((size_t)blk * T + r) * 512 + cc0; const f32x4 l1 = *(const f32x4*)(LB + cc0), l2 = *(const f32x4*)(LB + cc0 + 16);
                        const f32x4 s1 = {sigmoid_(x1.x), sigmoid_(x1.y), sigmoid_(x1.z), sigmoid_(x1.w)}, s2 = {sigmoid_(x2.x), sigmoid_(x2.y), sigmoid_(x2.z), sigmoid_(x2.w)};
                        const f32x4 f1 = l1 + (1.f - l1) * s1, f2 = l2 + (1.f - l2) * s2;
                        *(f32x4*)LF = (f32x4){__logf(f1.x), __logf(f1.y), __logf(f1.z), __logf(f1.w)}; *(f32x4*)(LF + 16) = (f32x4){__logf(f2.x), __logf(f2.y), __logf(f2.z), __logf(f2.w)};
                    } else if (blk == 3 || blk == 7) { const int t = r & (SEQ - 1); rope_pair(x1, x2, (float)((wc >> 1) ? (t & 63) : (t >> 6)), inv);
                        if (blk == 3) { ::bf16* d = (::bf16*)(ws + WS_KR) + (size_t)r * 512 + lc0; *(u32x2*)d = pk4(x1 * HEAD_SCALE); *(u32x2*)(d + 32) = pk4(x2 * HEAD_SCALE); }
                        else { ::bf16* d = (::bf16*)(ws + WS_QS) + (size_t)r * 1024 + 512 + lc0; *(u32x2*)d = pk4(x1); *(u32x2*)(d + 32) = pk4(x2); }
                    } else { ::bf16* d;
                        if (blk == 2) d = (::bf16*)(ws + WS_VS) + (size_t)r * 1024 + cc0; else if (blk == 4) d = (::bf16*)(ws + WS_VS) + (size_t)r * 1024 + 512 + cc0;
                        else if (blk == 5) { d = (::bf16*)(ws + WS_QS) + (size_t)r * 1024 + cc0; x1 = silu4(x1) * HEAD_SCALE; x2 = silu4(x2) * HEAD_SCALE; }
                        else if (blk == 6) d = (::bf16*)(ws + WS_G) + (size_t)r * 1024 + cc0; else d = (::bf16*)(ws + WS_G) + (size_t)r * 1024 + 512 + cc0;
                        *(u32x2*)d = pk4(x1); *(u32x2*)(d + 16) = pk4(x2); } } }
    }
};
struct EpiResidP {
    static constexpr bool PERM = true, AFTER_DRAIN = false; float* XA; const float* gate; ::bf16* Hn; const float* ng; const float* sc; float* RSS;
    DEVI void operator()(const f32x4 (&acc)[2][2][4][2], const Unit& u, int wr, int wc, int fr, int fq) const {
        const int bi = (u.pm * BM) >> 13; const float* g = gate + (size_t)bi * 6144; const float* s2 = sc + (size_t)bi * 6144;
        float ss[2][4];
#pragma unroll
        for (int ai = 0; ai < 2; ++ai)
#pragma unroll
            for (int m = 0; m < 4; ++m) ss[ai][m] = 0.f;
#pragma unroll
        for (int bj = 0; bj < 2; ++bj) { const int c = u.pn * BM + 128 * bj + 32 * wc + 8 * fq; const f32x4 g0 = *(const f32x4*)(g + c), g1 = *(const f32x4*)(g + c + 4);
            const f32x4 m0 = *(const f32x4*)(ng + c) * (*(const f32x4*)(s2 + c) + 1.f), m1 = *(const f32x4*)(ng + c + 4) * (*(const f32x4*)(s2 + c + 4) + 1.f);
#pragma unroll
            for (int ai = 0; ai < 2; ++ai)
#pragma unroll
                for (int m = 0; m < 4; ++m) { const size_t o = (size_t)(u.pm * BM + 128 * ai + 64 * wr + 16 * m + fr) * 1024 + c; f32x4* xp = (f32x4*)(XA + o);
                    const f32x4 x0 = xp[0] + g0 * acc[ai][bj][m][0], x1 = xp[1] + g1 * acc[ai][bj][m][1]; xp[0] = x0; xp[1] = x1;
                    const u32x2 lo = pk4(x0 * m0), hi = pk4(x1 * m1); *(u32x4*)(Hn + o) = (u32x4){lo.x, lo.y, hi.x, hi.y};
                    ss[ai][m] += (x0.x * x0.x + x0.y * x0.y + x0.z * x0.z + x0.w * x0.w) + (x1.x * x1.x + x1.y * x1.y + x1.z * x1.z + x1.w * x1.w); } }
#pragma unroll
        for (int ai = 0; ai < 2; ++ai)
#pragma unroll
            for (int m = 0; m < 4; ++m) { float v = ss[ai][m]; v += __shfl_xor(v, 16); v += __shfl_xor(v, 32); if (fq == 0) RSS[(size_t)(u.pm * BM + 128 * ai + 64 * wr + 16 * m + fr) * 16 + u.pn * 4 + wc] = v; }
    }
};
struct EpiBf16P {
    static constexpr bool PERM = true, AFTER_DRAIN = false; ::bf16* O; int ld; const float* RSS; const float* shq;
    DEVI void operator()(const f32x4 (&acc)[2][2][4][2], const Unit& u, int wr, int wc, int fr, int fq) const {
        const float* sq = shq + (size_t)((u.pm * BM) >> 13) * 2048;
        float rs[2][4];
#pragma unroll
        for (int ai = 0; ai < 2; ++ai)
#pragma unroll
            for (int m = 0; m < 4; ++m) rs[ai][m] = rss_rstd(RSS + (size_t)(u.pm * BM + 128 * ai + 64 * wr + 16 * m + fr) * 16);
#pragma unroll
        for (int bj = 0; bj < 2; ++bj) { const int c = u.pn * BM + 128 * bj + 32 * wc + 8 * fq; const f32x4 q0 = *(const f32x4*)(sq + c), q1 = *(const f32x4*)(sq + c + 4);
#pragma unroll
            for (int ai = 0; ai < 2; ++ai)
#pragma unroll
                for (int m = 0; m < 4; ++m) { const u32x2 lo = pk4(acc[ai][bj][m][0] * rs[ai][m] + q0), hi = pk4(acc[ai][bj][m][1] * rs[ai][m] + q1);
                    *(u32x4*)(O + (size_t)(u.pm * BM + 128 * ai + 64 * wr + 16 * m + fr) * ld + c) = (u32x4){lo.x, lo.y, hi.x, hi.y}; } }
    }
};
template <class Epi> DEVI void run(const ::bf16* A, const ::bf16* Bt, int N, unsigned char* lds, const Epi& E) {
    Gemm g{A, Bt, TX, N, 1024}; StaticOrder S; S.init(TX, N, (int)gridDim.x, (int)blockIdx.x);
    gemm_phase<Epi, StaticOrder, true, true>((PG8_LAS unsigned char*)lds, g, S, E);
}
}
#define OPT_GEMM 1

DEVI bool phase_nonempty(int ph) {
    if (ph == 0) return true;
    if (ph == NPHASES - 1) return false;
    const int L = (ph - 1) / NPH_LAYER, s = (ph - 1) % NPH_LAYER;
    if ((L & 1) == 0 && (s == 4 || s == 5 || s == 6)) return false;
    if (OPT_GEMM && (s == 2 || s == 8 || s == 10)) return false;
    if (s == 0 && L > 0) return false;
    return true;
}
DEVI void run_phase(const Params& p, int ph, float* smem) {
    if (ph == 0) { ph_prologue(p, smem); if (OPT_GEMM) { __syncthreads(); ph_weights(p, smem); ph_subkeys(p); ph_gmlp_weights(p); } return; }
    if (ph == NPHASES - 1) return;
    const int L = (ph - 1) / NPH_LAYER, s = (ph - 1) % NPH_LAYER, jl = L >> 1; const bool even = (L & 1) == 0;
    const bf16* H = (const bf16*)(p.ws + WS_H); const float* MOD = (const float*)(p.ws + WS_MOD);
    unsigned char* lds = (unsigned char*)smem;
    { const bool split = !even && gridDim.x >= 256; if (s == (split ? 4 : 9)) ph_tables(p, L, split ? 128 : 0, split ? (int)gridDim.x - 128 : (int)gridDim.x); }
    switch (s) {
    case 0: if (L == 0) { ph_norm(p, L, 0); ph_shq(p, smem); } break;
    case 1:
            if (even) { const bf16* W = (const bf16*)(p.ws + WT_INE) + (size_t)jl * 2560 * 1024; pg8::EpiEvenP e8{p.ws}; pg8::run(H, W, 2560, lds, e8); EpiEven e{p.ws}; gemm_mfma(H, W, 2560, lds, e, true); }
            else { const bf16* W = (const bf16*)(p.ws + WT_INO) + (size_t)jl * 4608 * 1024; const float* LBl = (const float*)(p.ws + WS_LB) + L * 512; pg8::EpiOddP e8{p.ws, LBl}; pg8::run(H, W, 4608, lds, e8); EpiOdd e{p.ws, LBl}; gemm_mfma(H, W, 4608, lds, e, true); }
            break;
    case 2: break;
    case 3: if (even) { ph_gmlp(p, L, lds); __syncthreads(); ph_attn(p, L, lds); } else ph_scan1(p, L, lds); break;
    case 4: if (!even) ph_scan2(p); break;
    case 5: if (!even) ph_scan3(p, L, lds); break;
    case 6: if (!even) ph_scan4_naive(p, L); break;
    case 7:
            { const bf16* W = (const bf16*)(p.ws + WT_OUT) + (size_t)L * 1024 * 1024; const float* gt = MOD + (size_t)L * 3 * 6144 + 2048; const float* ng = p.norm_g + (L * 2 + 1) * 1024; const float* sc2 = MOD + (size_t)L * 3 * 6144 + 4096;
              bf16* Hn = (bf16*)(p.ws + WS_H); float* RSS = (float*)(p.ws + WS_RSS) + (size_t)L * T * 16;
              pg8::EpiResidP e8{(float*)(p.ws + WS_XA), gt, Hn, ng, sc2, RSS}; pg8::run((const bf16*)(p.ws + WS_OX), W, 1024, lds, e8);
              if (L != DEPTH - 1) { EpiResid e{(float*)(p.ws + WS_XA), gt, Hn, ng, sc2, RSS}; gemm_mfma((const bf16*)(p.ws + WS_OX), W, 1024, lds, e, true); } }
            break;
    case 8: break;
    case 9:
            {
              const bf16* W = (const bf16*)(p.ws + WT_Q) + (size_t)L * 2048 * 1024; const float* RSS = (const float*)(p.ws + WS_RSS) + (size_t)L * T * 16; const float* shq = (const float*)(p.ws + WS_SHQ) + (size_t)L * 3 * 2048;
              pg8::EpiBf16P e8{(bf16*)(p.ws + WS_QP), 2048, RSS, shq}; pg8::run(H, W, 2048, lds, e8); if (L != DEPTH - 1) { EpiBf16Out e{(bf16*)(p.ws + WS_QP), 2048, RSS, shq}; gemm_mfma(H, W, 2048, lds, e, true); } }
            break;
    case 10: break;
    case 11: ph_peer_select(p, L, smem); break;
    case 12:
#if defined(PROF_GATHER)
            ph_peer_gather<true>(p, L, smem); __syncthreads();
#endif
#if defined(PROF_GDRY)
            ph_gather_dry(p, L); __syncthreads();
#endif
            ph_peer_gather<false>(p, L, smem); break;
    }
}

constexpr int LDS_BYTES = 64 + 132 * 1024;
__global__ void __launch_bounds__(NTHR) mega(Params p) {
    extern __shared__ __attribute__((aligned(16))) unsigned char lds_raw[];
    float* smem = (float*)(lds_raw + 64);
    volatile unsigned* st = (volatile unsigned*)lds_raw;
#if MK_SINGLE
    if (threadIdx.x < 16) st[threadIdx.x] = 0u;
    __syncthreads();
    XcdBarrier bar = xcd_barrier_post((unsigned*)(p.ws + WS_CTL) + 4096, st);
#endif
    for (int ph = p.ph_lo; ph < p.ph_hi; ++ph) {
        if (!phase_nonempty(ph)) continue;
        Params q = p;
        { const float** qq = (const float**)&q;
#pragma unroll
          for (int i = 0; i < 24; ++i) { const float __attribute__((address_space(1)))* gpt = (const float __attribute__((address_space(1)))*)qq[i]; asm volatile("" : "+s"(gpt)); qq[i] = (const float*)gpt; }
          { unsigned char __attribute__((address_space(1)))* gw = (unsigned char __attribute__((address_space(1)))*)q.ws; asm volatile("" : "+s"(gw)); q.ws = (unsigned char*)gw; }
          { float __attribute__((address_space(1)))* go = (float __attribute__((address_space(1)))*)q.out; asm volatile("" : "+s"(go)); q.out = (float*)go; } }
        {
            int nrep = 1;
#if defined(PROF_STEP)
            if (ph > 0 && ph < NPHASES - 1 && (ph - 1) % NPH_LAYER == PROF_STEP && (((ph - 1) / NPH_LAYER) & 1) == PROF_PAR) nrep += (p.ph_lo == 0) ? PROF_NREP : 0;
#endif
            for (int rep = 0; rep < nrep; ++rep) { if (rep) __syncthreads(); run_phase(q, ph, smem); }
        }
#if MK_SINGLE
        if (ph + 1 < p.ph_hi) xcd_barrier(bar);
#endif
    }
}

extern "C" void kernel_launch(void* const* d_in, const int* in_sizes, int n_in, void* d_out, int out_size, void* d_ws, size_t ws_size, hipStream_t stream) {
    static int grid = 0;
    if (grid == 0) {
        if (n_in != 24 || out_size != TX * D || ws_size < WS_END) { fprintf(stderr, "kernel_launch: unexpected shapes (n_in %d out %d ws %zu)\n", n_in, out_size, ws_size); grid = -1; return; }
        int dev = 0, cus = 0, per_cu = 0;
        (void)hipGetDevice(&dev); (void)hipDeviceGetAttribute(&cus, hipDeviceAttributeMultiprocessorCount, dev);
        (void)hipFuncSetAttribute((const void*)mega, hipFuncAttributeMaxDynamicSharedMemorySize, LDS_BYTES);
        if (hipOccupancyMaxActiveBlocksPerMultiprocessor(&per_cu, (const void*)mega, NTHR, LDS_BYTES) != hipSuccess || per_cu < 1) per_cu = 1;
        if (per_cu > 1) per_cu = 1;
        grid = cus * per_cu;
        fprintf(stderr, "kernel_launch: grid %d (%d CUs x %d)\n", grid, cus, per_cu);
    }
    if (grid < 0) return;
    Params p{};
    const float** pp = (const float**)&p;
    for (int i = 0; i < 24; ++i) pp[i] = (const float*)d_in[i];
    p.out = (float*)d_out; p.ws = (unsigned char*)d_ws;
#if MK_SINGLE
    (void)hipMemsetAsync((char*)d_ws + WS_CTL, 0, 1 * MiB, stream);
    p.ph_lo = 0; p.ph_hi = NPHASES;
    void* args[] = {&p};
    hipError_t e = hipLaunchCooperativeKernel((const void*)mega, dim3(grid), dim3(NTHR), args, LDS_BYTES, stream);
    if (e != hipSuccess) fprintf(stderr, "cooperative launch failed: %s (grid %d)\n", hipGetErrorString(e), grid);
#else
    for (int ph = 0; ph < NPHASES; ++ph) {
        bool ne = true;
        if (ph != 0 && ph != NPHASES - 1) { const int L = (ph - 1) / NPH_LAYER, s = (ph - 1) % NPH_LAYER; if ((L & 1) == 0 && (s == 4 || s == 5 || s == 6)) ne = false; }
        if (!ne) continue;
        p.ph_lo = ph; p.ph_hi = ph + 1;
        hipLaunchKernelGGL(mega, dim3(grid), dim3(NTHR), LDS_BYTES, stream, p);
    }
#endif
}
```

```cpp
#include <hip/hip_runtime.h>
#include <cstdio>
#include <cstdint>

#ifndef MK_SINGLE
#define MK_SINGLE 1
#endif

#define DEVI __device__ __forceinline__
#define LAS __attribute__((address_space(3)))

typedef unsigned short bf16;
typedef float f32x4 __attribute__((ext_vector_type(4)));
typedef unsigned u32x4 __attribute__((ext_vector_type(4)));
typedef unsigned u32x2 __attribute__((ext_vector_type(2)));
typedef float f32x2 __attribute__((ext_vector_type(2)));

constexpr int D = 1024, SEQ = 8192, NCTX = 256, DEPTH = 4;
constexpr int TX = 2 * SEQ, TC = 2 * NCTX, T = TX + TC;
constexpr int NSEQ = SEQ + NCTX;
constexpr int NCHUNK = NSEQ / 64;
constexpr float EPS = 1e-6f;
constexpr float LOG2E = 1.4426950408889634f;
constexpr float DIFF_SCALE = 0.125f, HEAD_SCALE = 0.08838834764831845f;
constexpr int NPH_LAYER = 13, NPHASES = 1 + DEPTH * NPH_LAYER + 1;
constexpr int NTHR = 512, NWV = NTHR / 64;

constexpr size_t MiB = 1u << 20;
constexpr size_t WS_CTL = 0;
constexpr size_t WS_MOD = 1 * MiB;
constexpr size_t WS_LB = WS_MOD + 512 * 1024, WS_LAM = WS_MOD + 768 * 1024;
constexpr size_t WS_SHQ = WS_MOD + 800 * 1024;
constexpr size_t WS_RSS = 58 * MiB;
constexpr size_t WS_WT = 2 * MiB;
constexpr size_t WS_XA = 66 * MiB;
constexpr size_t WS_H = 132 * MiB;
constexpr size_t WS_OX = 165 * MiB;
constexpr size_t WS_ACT = 198 * MiB;
constexpr size_t TB512 = (size_t)T * 512 * 2;
constexpr size_t WS_KB = WS_ACT, WS_VB = WS_ACT + TB512, WS_QB = WS_ACT + 2 * TB512, WS_UB = WS_ACT + 3 * TB512, WS_VG = WS_ACT + 4 * TB512;
constexpr size_t WS_LF = WS_ACT;
constexpr size_t WS_VS = WS_ACT + 66 * MiB;
constexpr size_t WS_KR = WS_VS + 33 * MiB;
constexpr size_t WS_QS = WS_KR + TB512;
constexpr size_t WS_G = WS_QS + 33 * MiB;
constexpr size_t WS_OFB = 390 * MiB;
constexpr size_t WS_UT = 522 * MiB;
constexpr size_t WS_DEC = 786 * MiB;
constexpr size_t WS_QP = 522 * MiB;
constexpr size_t WS_SC = 588 * MiB;
constexpr size_t WS_EID = 720 * MiB;
constexpr size_t WS_GATE = 729 * MiB;
constexpr size_t WS_R = 390 * MiB;
constexpr size_t WS_SCR = 522 * MiB;
constexpr size_t WS_TAB = 792 * MiB;
constexpr size_t WS_END = 856 * MiB;

struct Params {
    const float *x, *c, *ctx, *c_ctx, *w_ada, *b_ada, *norm_g, *w_in_even, *gmlp_ws, *gmlp_bs, *gmlp_v_gain, *diff_lambda, *diff_sub_gain,
        *w_in_odd, *hgrn_lb, *hgrn_gain, *ret_log_decay, *ret_gain, *w_out, *peer_wq, *peer_sub_keys, *peer_u, *peer_v, *final_g;
    float* out; unsigned char* ws; int ph_lo, ph_hi;
};

DEVI float bf2f(bf16 h) { return __uint_as_float((unsigned)h << 16); }
DEVI unsigned f2bf(float f) { unsigned u = __float_as_uint(f); return (u + 0x7fffu + ((u >> 16) & 1u)) >> 16; }
typedef __bf16 bf16x2n __attribute__((ext_vector_type(2)));
DEVI unsigned pk2(float lo, float hi) { const bf16x2n v = {(__bf16)lo, (__bf16)hi}; return __builtin_bit_cast(unsigned, v); }
DEVI u32x2 pk4(const f32x4 v) { u32x2 o; o.x = pk2(v.x, v.y); o.y = pk2(v.z, v.w); return o; }
DEVI float clamp8(float x) { return __builtin_amdgcn_fmed3f(x, -240.f, 240.f); }
DEVI unsigned pk4f8(float a, float b, float c, float d) { int w = __builtin_amdgcn_cvt_pk_fp8_f32(clamp8(a), clamp8(b), 0, false); w = __builtin_amdgcn_cvt_pk_fp8_f32(clamp8(c), clamp8(d), w, true); return (unsigned)w; }
DEVI f32x4 up4f8(unsigned w) { const f32x2 a = __builtin_amdgcn_cvt_pk_f32_fp8((int)w, false), b = __builtin_amdgcn_cvt_pk_f32_fp8((int)w, true); return (f32x4){a.x, a.y, b.x, b.y}; }
DEVI float bflo(unsigned w) { return __uint_as_float(w << 16); }
DEVI float bfhi(unsigned w) { return __uint_as_float(w & 0xffff0000u); }
template <int M> DEVI float swz_xor(float x) { return __builtin_bit_cast(float, __builtin_amdgcn_ds_swizzle(__builtin_bit_cast(int, x), 0x1F | (M << 10))); }
DEVI float x32_sum(float x) { auto r = __builtin_amdgcn_permlane32_swap(__float_as_uint(x), __float_as_uint(x), false, false); return __uint_as_float(r[0]) + __uint_as_float(r[1]); }
DEVI float x32_max(float x) { auto r = __builtin_amdgcn_permlane32_swap(__float_as_uint(x), __float_as_uint(x), false, false); return fmaxf(__uint_as_float(r[0]), __uint_as_float(r[1])); }
DEVI float row16_sum(float d) {
    d += __builtin_bit_cast(float, __builtin_amdgcn_update_dpp(0, __builtin_bit_cast(int, d), 0xB1, 0xF, 0xF, true));
    d += __builtin_bit_cast(float, __builtin_amdgcn_update_dpp(0, __builtin_bit_cast(int, d), 0x4E, 0xF, 0xF, true));
    d += __builtin_bit_cast(float, __builtin_amdgcn_update_dpp(0, __builtin_bit_cast(int, d), 0x141, 0xF, 0xF, true));
    d += __builtin_bit_cast(float, __builtin_amdgcn_update_dpp(0, __builtin_bit_cast(int, d), 0x140, 0xF, 0xF, true));
    return d;
}
DEVI float row16_max(float d) {
    d = fmaxf(d, __builtin_bit_cast(float, __builtin_amdgcn_update_dpp(0, __builtin_bit_cast(int, d), 0xB1, 0xF, 0xF, true)));
    d = fmaxf(d, __builtin_bit_cast(float, __builtin_amdgcn_update_dpp(0, __builtin_bit_cast(int, d), 0x4E, 0xF, 0xF, true)));
    d = fmaxf(d, __builtin_bit_cast(float, __builtin_amdgcn_update_dpp(0, __builtin_bit_cast(int, d), 0x141, 0xF, 0xF, true)));
    d = fmaxf(d, __builtin_bit_cast(float, __builtin_amdgcn_update_dpp(0, __builtin_bit_cast(int, d), 0x140, 0xF, 0xF, true)));
    return d;
}
DEVI float half_sum(float v) { v = row16_sum(v); return v + swz_xor<16>(v); }
DEVI float half_max(float v) { v = row16_max(v); return fmaxf(v, swz_xor<16>(v)); }
DEVI float wave_sum(float v) { return x32_sum(half_sum(v)); }
DEVI float wave_max(float v) { return x32_max(half_max(v)); }
DEVI float sigmoid_(float x) { return 1.f / (1.f + __expf(-x)); }
DEVI float silu_(float x) { return x * sigmoid_(x); }
DEVI float gelu_(float x) { const float u = 1.5957691216057308f * (x + 0.044715f * x * x * x); return x / (1.f + __expf(-u)); }
DEVI int mod_index(int r) { return r < TX ? (r >> 13) : 2; }
DEVI float rss_rstd(const float* rssp) { const f32x4 a = *(const f32x4*)rssp, b = *(const f32x4*)(rssp + 4), c = *(const f32x4*)(rssp + 8), d = *(const f32x4*)(rssp + 12);
    const float s = ((a.x + a.y) + (a.z + a.w)) + ((b.x + b.y) + (b.z + b.w)) + (((c.x + c.y) + (c.z + c.w)) + ((d.x + d.y) + (d.z + d.w))); return rsqrtf(s * (1.f / 1024.f) + EPS); }
template <int L> DEVI int rope_partner(int cc) { constexpr int Q = L / 4; return ((cc % (L / 2)) < Q) ? cc + Q : cc - Q; }
template <int L> DEVI float rope_apply(int cc, float self, float partner, int grow, int gcol) {
    constexpr int Q = L / 4;
    const int sec = cc / (L / 2), c2 = cc % (L / 2), i = c2 % Q; const bool first = c2 < Q;
    const float pos = (float)(sec ? gcol : grow);
    const float inv = exp2f(-(float)i * (13.287712379549449f / (float)Q));
    const float ang = pos * inv; const float cs = __cosf(ang), sn = __sinf(ang);
    return first ? (self * cs - partner * sn) : (partner * sn + self * cs);
}
DEVI int scan_row(int b, int dir, int j) {
    if (j < NCTX) return TX + b * NCTX + (dir ? NCTX - 1 - j : j);
    const int t = j - NCTX; return b * SEQ + (dir ? SEQ - 1 - t : t);
}

#define XB_TMO 128
#define XB_XCNT(j) (256 + 64 * (j))
#define XB_XSUB(j) (1280 + 64 * (j))
#define XB_XGEN(j) (2304 + 64 * (j))
#define XB_TOP 3328
#define XB_TOPGEN 3392
#define XB_SPIN_CAP (1u << 22)
DEVI unsigned xb_ld(unsigned* p) { return __hip_atomic_load(p, __ATOMIC_RELAXED, __HIP_MEMORY_SCOPE_AGENT); }
DEVI unsigned xb_add(unsigned* p, unsigned v) { return __hip_atomic_fetch_add(p, v, __ATOMIC_RELAXED, __HIP_MEMORY_SCOPE_AGENT); }
DEVI unsigned xb_xcc_id() { return (unsigned)__builtin_amdgcn_s_getreg((3 << 11) | 20) & 0xFu; }
#define XB_SPIN(cond, bar) do { unsigned _sp = 0; while (cond) { __builtin_amdgcn_s_sleep(1); \
    if ((++_sp & 255u) == 0u) { if (xb_ld(&(bar)[XB_TMO])) break; if (_sp > XB_SPIN_CAP) { atomicAdd(&(bar)[XB_TMO], 1u); break; } } } } while (0)
struct XcdBarrier { unsigned* bar; unsigned x; volatile unsigned* st; };
DEVI XcdBarrier xcd_barrier_post(unsigned* bar, volatile unsigned* st) {
    XcdBarrier b; b.bar = bar; b.x = xb_xcc_id(); b.st = st;
    if (threadIdx.x == 0) (void)xb_add(&bar[XB_XCNT(b.x)], 1u);
    return b;
}
DEVI void xcd_barrier_complete(unsigned* bar, unsigned x, unsigned& nloc, unsigned& nx) {
    const unsigned G = gridDim.x; unsigned sum, cnt, mine, sp = 0u;
    for (;;) {
        sum = 0u; cnt = 0u; mine = 0u;
#pragma unroll
        for (unsigned j = 0; j < 16; ++j) { const unsigned c = xb_ld(&bar[XB_XCNT(j)]); sum += c; cnt += (c > 0u) ? 1u : 0u; mine = (j == x) ? c : mine; }
        if (sum == G) break;
        __builtin_amdgcn_s_sleep(1);
        if ((++sp & 255u) == 0u) { if (xb_ld(&bar[XB_TMO])) break; if (sp > XB_SPIN_CAP) { atomicAdd(&bar[XB_TMO], 1u); break; } }
    }
    nloc = mine > 0u ? mine : 1u; nx = cnt > 0u ? cnt : 1u;
}
DEVI void xcd_barrier(const XcdBarrier& b) {
    asm volatile("s_waitcnt vmcnt(0)" ::: "memory");
    __syncthreads();
    if (threadIdx.x == 0) {
        unsigned* bar = b.bar;
        __builtin_amdgcn_s_waitcnt(0);
        unsigned nloc = b.st[0], nx = b.st[1];
        if (nloc == 0u) { xcd_barrier_complete(bar, b.x, nloc, nx); b.st[0] = nloc; b.st[1] = nx; }
        const unsigned old = xb_add(&bar[XB_XSUB(b.x)], 1u);
        const unsigned gen = old / nloc;
        if (old + 1u == (gen + 1u) * nloc) {
            __builtin_amdgcn_fence(__ATOMIC_RELEASE, "agent");
            asm volatile("s_waitcnt vmcnt(0)" ::: "memory");
            const unsigned og = xb_add(&bar[XB_TOP], 1u);
            const unsigned tg = og / nx;
            if (og + 1u == (tg + 1u) * nx) xb_add(&bar[XB_TOPGEN], 1u);
            else XB_SPIN(xb_ld(&bar[XB_TOPGEN]) == tg, bar);
            __builtin_amdgcn_fence(__ATOMIC_ACQUIRE, "agent");
            xb_add(&bar[XB_XGEN(b.x)], 1u);
            asm volatile("s_waitcnt vmcnt(0)" ::: "memory");
        } else {
            XB_SPIN(xb_ld(&bar[XB_XGEN(b.x)]) == gen, bar);
            __builtin_amdgcn_fence(__ATOMIC_ACQUIRE, "agent");
            asm volatile("s_waitcnt vmcnt(0)" ::: "memory");
        }
    }
    __syncthreads();
}

DEVI int tidx() { int t = threadIdx.x; asm volatile("" : "+v"(t)); return t; }
DEVI void ph_prologue(const Params& p, float* smem) {
    float* MOD = (float*)(p.ws + WS_MOD);
    const int tid = tidx(), w = tid >> 6, lane = tid & 63;
    for (int it = blockIdx.x; it < 4 * 48; it += gridDim.x) {
        const int layer = it / 48, n0 = (it % 48) * 128;
        const float* W = p.w_ada + (size_t)layer * 1024 * 6144 + n0 + 2 * lane;
        float* sv = smem; float* red = smem + 3 * 1024;
        __syncthreads();
        for (int i = tid; i < 3 * 1024; i += NTHR) { const int v = i >> 10, k = i & 1023; sv[i] = silu_(v == 0 ? p.c[k] : v == 1 ? p.c[1024 + k] : p.c_ctx[k]); }
        __syncthreads();
        f32x2 a0 = {0.f, 0.f}, a1 = {0.f, 0.f}, a2 = {0.f, 0.f};
#pragma unroll 16
        for (int kk = 0; kk < 128; ++kk) { const int k = w * 128 + kk; const f32x2 wv = *(const f32x2*)(W + (size_t)k * 6144);
            a0 += wv * sv[k]; a1 += wv * sv[1024 + k]; a2 += wv * sv[2048 + k]; }
        *(f32x2*)(red + (w * 3 + 0) * 128 + 2 * lane) = a0; *(f32x2*)(red + (w * 3 + 1) * 128 + 2 * lane) = a1; *(f32x2*)(red + (w * 3 + 2) * 128 + 2 * lane) = a2;
        __syncthreads();
        if (tid < 384) { const int v = tid >> 7, cidx = tid & 127; float sacc = p.b_ada[layer * 6144 + n0 + cidx];
#pragma unroll
            for (int ww = 0; ww < NWV; ++ww) sacc += red[(ww * 3 + v) * 128 + cidx];
            MOD[(size_t)(layer * 3 + v) * 6144 + n0 + cidx] = sacc; }
    }
    if (blockIdx.x == 0) {
        float* LB = (float*)(p.ws + WS_LB);
        for (int ch = tid; ch < 512; ch += NTHR) {
            const float p0 = p.hgrn_lb[ch], p1 = p.hgrn_lb[512 + ch], p2 = p.hgrn_lb[1024 + ch], p3 = p.hgrn_lb[1536 + ch];
            const float m = fmaxf(fmaxf(p0, p1), fmaxf(p2, p3));
            const float e0 = __expf(p0 - m), e1 = __expf(p1 - m), e2 = __expf(p2 - m), e3 = __expf(p3 - m), s = e0 + e1 + e2 + e3;
            LB[ch] = 0.f; LB[512 + ch] = e1 / s; LB[1024 + ch] = (e1 + e2) / s; LB[1536 + ch] = (e1 + e2 + e3) / s;
        }
        if (tid < 2) {
            const float* lv = p.diff_lambda + tid * 256; float d01 = 0.f, d23 = 0.f;
            for (int i = 0; i < 64; ++i) { d01 += lv[i] * lv[64 + i]; d23 += lv[128 + i] * lv[192 + i]; }
            const float lam_init = tid == 0 ? 0.2f : 0.47071301834f;
            ((float*)(p.ws + WS_LAM))[tid] = __expf(d01) - __expf(d23) + lam_init;
        }
    }
}

DEVI void ph_shq(const Params& p, float* smem) {
    const float* MOD = (const float*)(p.ws + WS_MOD); float* SHQ = (float*)(p.ws + WS_SHQ);
    const int tid = tidx(), w = tid >> 6, lane = tid & 63;
    for (int it = blockIdx.x; it < 4 * 16; it += gridDim.x) {
        const int layer = it >> 4, n0 = (it & 15) * 128;
        const float* W = p.peer_wq + (size_t)layer * 1024 * 2048 + n0 + 2 * lane;
        float* sv = smem; float* red = smem + 3 * 1024;
        __syncthreads();
        for (int i = tid; i < 3 * 1024; i += NTHR) sv[i] = MOD[(size_t)(layer * 3 + (i >> 10)) * 6144 + 3072 + (i & 1023)];
        __syncthreads();
        f32x2 a0 = {0.f, 0.f}, a1 = {0.f, 0.f}, a2 = {0.f, 0.f};
#pragma unroll 8
        for (int kk = 0; kk < 128; ++kk) { const int k = w * 128 + kk; const f32x2 wv = *(const f32x2*)(W + (size_t)k * 2048);
            a0 += wv * sv[k]; a1 += wv * sv[1024 + k]; a2 += wv * sv[2048 + k]; }
        *(f32x2*)(red + (w * 3 + 0) * 128 + 2 * lane) = a0; *(f32x2*)(red + (w * 3 + 1) * 128 + 2 * lane) = a1; *(f32x2*)(red + (w * 3 + 2) * 128 + 2 * lane) = a2;
        __syncthreads();
        if (tid < 384) { const int v = tid >> 7, cidx = tid & 127; float sacc = 0.f;
#pragma unroll
            for (int ww = 0; ww < NWV; ++ww) sacc += red[(ww * 3 + v) * 128 + cidx];
            SHQ[(size_t)(layer * 3 + v) * 2048 + n0 + cidx] = sacc; }
    }
}
DEVI void ph_norm(const Params& p, int layer, int which) {
    bf16* XA = (bf16*)(p.ws + WS_XA); bf16* H = (bf16*)(p.ws + WS_H); const float* MOD = (const float*)(p.ws + WS_MOD);
    const int lane = tidx() & 63, gw = blockIdx.x * NWV + (tidx() >> 6), NW = gridDim.x * NWV;
    const float* g = p.norm_g + (layer * 2 + which) * 1024;
    for (int r = gw; r < T; r += NW) {
        const f32x4* xr = (const f32x4*)(r < TX ? p.x + (size_t)r * 1024 : p.ctx + (size_t)(r - TX) * 1024);
        const float* m = MOD + (size_t)(layer * 3 + mod_index(r)) * 6144 + which * 3072;
        f32x4 v[4], g4v[4], shv[4], scv[4]; float ss = 0.f;
#pragma unroll
        for (int j = 0; j < 4; ++j) { const int col = (j * 64 + lane) * 4; v[j] = xr[j * 64 + lane]; g4v[j] = *(const f32x4*)(g + col); shv[j] = *(const f32x4*)(m + col); scv[j] = *(const f32x4*)(m + 1024 + col); }
#pragma unroll
        for (int j = 0; j < 4; ++j) { ss += v[j].x * v[j].x + v[j].y * v[j].y + v[j].z * v[j].z + v[j].w * v[j].w; ((u32x2*)(XA + (size_t)r * 1024))[j * 64 + lane] = pk4(v[j]); }
        const float rstd = rsqrtf(wave_sum(ss) * (1.f / 1024.f) + EPS);
#pragma unroll
        for (int j = 0; j < 4; ++j) {
            const int col = (j * 64 + lane) * 4;
            const f32x4 g4 = g4v[j], sh = shv[j], sc = scv[j];
            const f32x4 h = v[j] * rstd * g4 * (sc + 1.f) + sh;
            u32x2 o; o.x = pk2(h.x, h.y); o.y = pk2(h.z, h.w);
            *(u32x2*)(H + (size_t)r * 1024 + col) = o;
        }
    }
}

DEVI void ph_scan4_naive(const Params& p, int layer) {
    const int jl = layer >> 1, lane = tidx() & 63, gw = blockIdx.x * NWV + (tidx() >> 6), NW = gridDim.x * NWV;
    const bf16* OFB = (const bf16*)(p.ws + WS_OFB); const bf16* G = (const bf16*)(p.ws + WS_G); bf16* OX = (bf16*)(p.ws + WS_OX);
    for (int r = gw; r < T; r += NW) {
#pragma unroll
        for (int j = 0; j < 2; ++j) {
            const int col = (j * 64 + lane) * 8, d = col & 127;
            const u32x4 of = *(const u32x4*)(OFB + (size_t)r * 1024 + col), ob = *(const u32x4*)(OFB + ((size_t)T + r) * 1024 + col), gg = *(const u32x4*)(G + (size_t)r * 1024 + col);
            float o[8], g[8], y[8];
            o[0] = bflo(of.x) + bflo(ob.x); o[1] = bfhi(of.x) + bfhi(ob.x); o[2] = bflo(of.y) + bflo(ob.y); o[3] = bfhi(of.y) + bfhi(ob.y);
            o[4] = bflo(of.z) + bflo(ob.z); o[5] = bfhi(of.z) + bfhi(ob.z); o[6] = bflo(of.w) + bflo(ob.w); o[7] = bfhi(of.w) + bfhi(ob.w);
            g[0] = bflo(gg.x); g[1] = bfhi(gg.x); g[2] = bflo(gg.y); g[3] = bfhi(gg.y); g[4] = bflo(gg.z); g[5] = bfhi(gg.z); g[6] = bflo(gg.w); g[7] = bfhi(gg.w);
            if (j == 0) {
                float ss = 0.f;
#pragma unroll
                for (int i = 0; i < 8; ++i) { o[i] *= sigmoid_(g[i]); ss += o[i] * o[i]; }
                const float rn = rsqrtf(row16_sum(ss) * (1.f / 128.f) + EPS);
                const f32x4 g0 = *(const f32x4*)(p.hgrn_gain + jl * 128 + d), g1 = *(const f32x4*)(p.hgrn_gain + jl * 128 + d + 4);
                y[0] = o[0] * rn * g0.x; y[1] = o[1] * rn * g0.y; y[2] = o[2] * rn * g0.z; y[3] = o[3] * rn * g0.w; y[4] = o[4] * rn * g1.x; y[5] = o[5] * rn * g1.y; y[6] = o[6] * rn * g1.z; y[7] = o[7] * rn * g1.w;
            } else {
                float sm = 0.f;
#pragma unroll
                for (int i = 0; i < 8; ++i) sm += o[i];
                const float mean = row16_sum(sm) * (1.f / 128.f); float ss = 0.f;
#pragma unroll
                for (int i = 0; i < 8; ++i) { o[i] -= mean; ss += o[i] * o[i]; }
                const float rn = rsqrtf(row16_sum(ss) * (1.f / 128.f) + EPS);
                const f32x4 g0 = *(const f32x4*)(p.ret_gain + jl * 128 + d), g1 = *(const f32x4*)(p.ret_gain + jl * 128 + d + 4);
                y[0] = o[0] * rn * g0.x * silu_(g[0]); y[1] = o[1] * rn * g0.y * silu_(g[1]); y[2] = o[2] * rn * g0.z * silu_(g[2]); y[3] = o[3] * rn * g0.w * silu_(g[3]);
                y[4] = o[4] * rn * g1.x * silu_(g[4]); y[5] = o[5] * rn * g1.y * silu_(g[5]); y[6] = o[6] * rn * g1.z * silu_(g[6]); y[7] = o[7] * rn * g1.w * silu_(g[7]);
            }
            u32x4 w; w.x = pk2(y[0], y[1]); w.y = pk2(y[2], y[3]); w.z = pk2(y[4], y[5]); w.w = pk2(y[6], y[7]); *(u32x4*)(OX + (size_t)r * 1024 + col) = w;
        }
    }
}

#define KEY_INSERT(K, key) do { _Pragma("unroll") for (int _j = 15; _j >= 1; --_j) K[_j] = __builtin_amdgcn_fmed3f(K[_j - 1], K[_j], (key)); K[0] = fmaxf(K[0], (key)); } while (0)
#define TOPK_INSERT(V, I, s, id) do { \
    _Pragma("unroll") for (int _j = 15; _j >= 1; --_j) { const bool _up = (s) > V[_j - 1]; const bool _in = (s) > V[_j]; \
        I[_j] = _up ? I[_j - 1] : (_in ? (id) : I[_j]); V[_j] = _up ? V[_j - 1] : (_in ? (s) : V[_j]); } \
    { const bool _in0 = (s) > V[0]; I[0] = _in0 ? (id) : I[0]; V[0] = _in0 ? (s) : V[0]; } } while (0)
typedef short bf16x8 __attribute__((ext_vector_type(8)));
constexpr size_t WT_INE = WS_WT, WT_INO = WS_WT + 10 * MiB, WT_OUT = WS_WT + 28 * MiB, WT_Q = WS_WT + 36 * MiB, WT_SK = WS_WT + 52 * MiB;

DEVI int perm_odd_col(int n) {
    const int blk = n >> 9; if (blk != 3 && blk != 7) return n;
    const int e = n & 127, sec = e >> 6, hlf = (e >> 5) & 1, i = e & 31; return (n & ~127) | (sec * 64 + (i >> 4) * 32 + hlf * 16 + (i & 15));
}
template <bool PERMODD> DEVI void transpose_item(const float* W, int K, int N, bf16* WT, float* scr, int item, int lane) {
    const int nblk = N / 32, kb = item / nblk, nb = item % nblk, k0 = 64 * kb, n0 = 32 * nb;
    f32x4 v[8];
#pragma unroll
    for (int i = 0; i < 8; ++i) v[i] = *(const f32x4*)(W + (size_t)(k0 + (lane >> 3) + 8 * i) * N + n0 + (lane & 7) * 4);
#pragma unroll
    for (int i = 0; i < 8; ++i) { float* d = scr + ((lane >> 3) + 8 * i) * 33 + (lane & 7) * 4; d[0] = v[i].x; d[1] = v[i].y; d[2] = v[i].z; d[3] = v[i].w; }
    asm volatile("s_waitcnt lgkmcnt(0)" ::: "memory"); __builtin_amdgcn_wave_barrier();
    const int c = lane & 7;
#pragma unroll
    for (int j = 0; j < 4; ++j) { const int n = (lane >> 3) + 8 * j; const float* s = scr + (8 * c) * 33 + n;
        u32x4 o; o.x = pk2(s[0 * 33], s[1 * 33]); o.y = pk2(s[2 * 33], s[3 * 33]); o.z = pk2(s[4 * 33], s[5 * 33]); o.w = pk2(s[6 * 33], s[7 * 33]);
        *(u32x4*)(WT + (size_t)(PERMODD ? perm_odd_col(n0 + n) : n0 + n) * K + k0 + 8 * c) = o; }
    asm volatile("s_waitcnt lgkmcnt(0)" ::: "memory"); __builtin_amdgcn_wave_barrier();
}
DEVI void ph_weights(const Params& p, float* smem) {
    const int wv = tidx() >> 6, lane = tidx() & 63, gw = blockIdx.x * NWV + wv, NW = gridDim.x * NWV;
    float* scr = smem + wv * (64 * 33);
    constexpr int I_E = 16 * (2560 / 32), I_O = 16 * (4608 / 32), I_W = 16 * (1024 / 32), I_Q = 16 * (2048 / 32);
    constexpr int NIT = 2 * I_E + 2 * I_O + 4 * I_W + 4 * I_Q;
    for (int it = gw; it < NIT; it += NW) {
        int r = it;
        if (r < 2 * I_E) { const int j = r / I_E; transpose_item<false>(p.w_in_even + (size_t)j * 1024 * 2560, 1024, 2560, (bf16*)(p.ws + WT_INE) + (size_t)j * 2560 * 1024, scr, r % I_E, lane); continue; } r -= 2 * I_E;
        if (r < 2 * I_O) { const int j = r / I_O; transpose_item<true>(p.w_in_odd + (size_t)j * 1024 * 4608, 1024, 4608, (bf16*)(p.ws + WT_INO) + (size_t)j * 4608 * 1024, scr, r % I_O, lane); continue; } r -= 2 * I_O;
        if (r < 4 * I_W) { const int j = r / I_W; transpose_item<false>(p.w_out + (size_t)j * 1024 * 1024, 1024, 1024, (bf16*)(p.ws + WT_OUT) + (size_t)j * 1024 * 1024, scr, r % I_W, lane); continue; } r -= 4 * I_W;
        { const int j = r / I_Q; transpose_item<false>(p.peer_wq + (size_t)j * 1024 * 2048, 1024, 2048, (bf16*)(p.ws + WT_Q) + (size_t)j * 2048 * 1024, scr, r % I_Q, lane); }
    }
}

constexpr int GEMM_BUF = 49152;
template <class Epi> DEVI void gemm_mfma(const bf16* A, const bf16* Wt, int N, unsigned char* lds, const Epi& epi, bool ctx_only) {
    const int tid = tidx(), wid = tid >> 6, lane = tid & 63, wr = wid >> 1, wc = wid & 1, fr = lane & 15, fq = lane >> 4;
    const int NT = N / 128;
    const int G = gridDim.x, nloc = G >> 3, xcd = blockIdx.x & 7, loc = blockIdx.x >> 3;
    const int bm = nloc >> 2, nmg = (64 + bm - 1) / bm, nng = NT >> 2, nmain = nmg * nng, nrounds = (nmain + 7) >> 3;
    int arow[4], ach[4], brow[2], bch[2];
#pragma unroll
    for (int i = 0; i < 4; ++i) { const int idx = tid + NTHR * i; arow[i] = idx >> 3; ach[i] = idx & 7; }
#pragma unroll
    for (int i = 0; i < 2; ++i) { const int idx = tid + NTHR * i; brow[i] = idx >> 3; bch[i] = idx & 7; }
    const int sw = fr & 7;
    for (int rd = ctx_only ? nrounds : 0; rd <= nrounds; ++rd) {
        int tm, tn;
        if (rd < nrounds) { const int sblk = rd * 8 + xcd; if (sblk >= nmain) continue; const int mg = sblk / nng, ng = sblk % nng; tm = mg * bm + (loc >> 2); tn = ng * 4 + (loc & 3); if (tm >= 64) continue; }
        else { const int t = G - 1 - (int)blockIdx.x; if (t >= 2 * NT) continue; tm = 64 + t / NT; tn = t % NT; }
        const int r0 = tm * 256, n0 = tn * 128;
        const bf16* Ag = A + (size_t)r0 * 1024; const bf16* Wg = Wt + (size_t)n0 * 1024;
        f32x4 acc[4][4];
#pragma unroll
        for (int a = 0; a < 4; ++a)
#pragma unroll
            for (int b = 0; b < 4; ++b) acc[a][b] = (f32x4){0.f, 0.f, 0.f, 0.f};
        u32x4 ra[4], rb[2];
#pragma unroll
        for (int i = 0; i < 4; ++i) ra[i] = *(const u32x4*)(Ag + (size_t)arow[i] * 1024 + ach[i] * 8);
#pragma unroll
        for (int i = 0; i < 2; ++i) rb[i] = *(const u32x4*)(Wg + (size_t)brow[i] * 1024 + bch[i] * 8);
        __syncthreads();
#pragma unroll
        for (int i = 0; i < 4; ++i) *(u32x4*)(lds + arow[i] * 128 + ((ach[i] ^ (arow[i] & 7)) << 4)) = ra[i];
#pragma unroll
        for (int i = 0; i < 2; ++i) *(u32x4*)(lds + 32768 + brow[i] * 128 + ((bch[i] ^ (brow[i] & 7)) << 4)) = rb[i];
        __syncthreads();
        for (int kt = 0; kt < 16; ++kt) {
            const int buf = kt & 1; unsigned char* la = lds + buf * GEMM_BUF; unsigned char* lb = la + 32768;
            if (kt + 1 < 16) {
#pragma unroll
                for (int i = 0; i < 4; ++i) ra[i] = *(const u32x4*)(Ag + (size_t)arow[i] * 1024 + (kt + 1) * 64 + ach[i] * 8);
#pragma unroll
                for (int i = 0; i < 2; ++i) rb[i] = *(const u32x4*)(Wg + (size_t)brow[i] * 1024 + (kt + 1) * 64 + bch[i] * 8);
            }
#pragma unroll
            for (int ks = 0; ks < 2; ++ks) {
                bf16x8 af[4], wf[4];
                const int ch = ((ks * 4 + fq) ^ sw) << 4;
#pragma unroll
                for (int m = 0; m < 4; ++m) af[m] = *(const bf16x8*)(la + (wr * 64 + m * 16 + fr) * 128 + ch);
#pragma unroll
                for (int n = 0; n < 4; ++n) wf[n] = *(const bf16x8*)(lb + (wc * 64 + n * 16 + fr) * 128 + ch);
#pragma unroll
                for (int m = 0; m < 4; ++m)
#pragma unroll
                    for (int n = 0; n < 4; ++n) acc[m][n] = __builtin_amdgcn_mfma_f32_16x16x32_bf16(wf[n], af[m], acc[m][n], 0, 0, 0);
            }
            if (kt + 1 < 16) {
                unsigned char* wa = lds + (buf ^ 1) * GEMM_BUF;
#pragma unroll
                for (int i = 0; i < 4; ++i) *(u32x4*)(wa + arow[i] * 128 + ((ach[i] ^ (arow[i] & 7)) << 4)) = ra[i];
#pragma unroll
                for (int i = 0; i < 2; ++i) *(u32x4*)(wa + 32768 + brow[i] * 128 + ((bch[i] ^ (brow[i] & 7)) << 4)) = rb[i];
            }
            __syncthreads();
        }
        epi(acc, r0 + wr * 64, n0 + wc * 64, fr, fq);
    }
}

template <class Epi> DEVI void gemm_ctx(const bf16* A, const bf16* Wt, int N, unsigned char* lds, const Epi& epi) {
    const int tid = tidx(), wid = __builtin_amdgcn_readfirstlane(tid >> 6), lane = tid & 63, fr = lane & 15, fq = lane >> 4;
    const int NT = N / 64, ntile = 8 * NT, G = gridDim.x;
    const int nmain = (TX / 256) * (N / 256), rem = nmain % G, nshare = rem ? G - rem : G, ib = G - 1 - (int)blockIdx.x;
    f32x4* red = (f32x4*)lds;
    if (ib < nshare) for (int t = ib; t < ntile; t += nshare) {
        const int tm = t / NT, tn = t - tm * NT, r0 = TX + tm * 64, n0 = tn * 64;
        const bf16* Ap = A + (size_t)(r0 + fr) * 1024 + wid * 128 + fq * 8; const bf16* Wp = Wt + (size_t)(n0 + fr) * 1024 + wid * 128 + fq * 8;
        f32x4 acc[4][4];
#pragma unroll
        for (int a = 0; a < 4; ++a)
#pragma unroll
            for (int b = 0; b < 4; ++b) acc[a][b] = (f32x4){0.f, 0.f, 0.f, 0.f};
        bf16x8 af[2][4], wf[2][4];
#pragma unroll
        for (int m = 0; m < 4; ++m) { af[0][m] = *(const bf16x8*)(Ap + (size_t)m * 16 * 1024); wf[0][m] = *(const bf16x8*)(Wp + (size_t)m * 16 * 1024); }
#pragma unroll
        for (int ks = 0; ks < 4; ++ks) {
            if (ks + 1 < 4) {
#pragma unroll
                for (int m = 0; m < 4; ++m) { af[(ks + 1) & 1][m] = *(const bf16x8*)(Ap + (size_t)m * 16 * 1024 + (ks + 1) * 32); wf[(ks + 1) & 1][m] = *(const bf16x8*)(Wp + (size_t)m * 16 * 1024 + (ks + 1) * 32); }
            }
#pragma unroll
            for (int m = 0; m < 4; ++m)
#pragma unroll
                for (int n = 0; n < 4; ++n) acc[m][n] = __builtin_amdgcn_mfma_f32_16x16x32_bf16(wf[ks & 1][n], af[ks & 1][m], acc[m][n], 0, 0, 0);
        }
        __syncthreads();
        if (wid != 0) {
#pragma unroll
            for (int m = 0; m < 4; ++m)
#pragma unroll
                for (int n = 0; n < 4; ++n) red[((wid - 1) * 16 + m * 4 + n) * 64 + lane] = acc[m][n];
        }
        __syncthreads();
        if (wid == 0) {
#pragma unroll 1
            for (int w = 0; w < 7; ++w)
#pragma unroll
                for (int m = 0; m < 4; ++m)
#pragma unroll
                    for (int n = 0; n < 4; ++n) acc[m][n] += red[(w * 16 + m * 4 + n) * 64 + lane];
            epi(acc, r0, n0, fr, fq);
        }
    }
}

template <int QTR> DEVI void rope_tile(f32x4 (&a)[4], int t, int sec128, int fq) {
    const int grow = t >> 6, gcol = t & 63;
    if (QTR == 16) {
#pragma unroll
        for (int s = 0; s < 2; ++s) { const float pos = (float)(s ? gcol : grow);
#pragma unroll
            for (int j = 0; j < 4; ++j) { const int i = fq * 4 + j; const float ang = pos * exp2f(-(float)i * (13.287712379549449f / 16.f)); const float cs = __cosf(ang), sn = __sinf(ang);
                const float x1 = a[2 * s][j], x2 = a[2 * s + 1][j]; a[2 * s][j] = x1 * cs - x2 * sn; a[2 * s + 1][j] = x1 * sn + x2 * cs; } }
    } else {
        const float pos = (float)(sec128 ? gcol : grow);
#pragma unroll
        for (int h = 0; h < 2; ++h)
#pragma unroll
            for (int j = 0; j < 4; ++j) { const int i = h * 16 + fq * 4 + j; const float ang = pos * exp2f(-(float)i * (13.287712379549449f / 32.f)); const float cs = __cosf(ang), sn = __sinf(ang);
                const float x1 = a[h][j], x2 = a[h + 2][j]; a[h][j] = x1 * cs - x2 * sn; a[h + 2][j] = x1 * sn + x2 * cs; }
    }
}
struct EpiEven {
    unsigned char* ws;
    DEVI void operator()(f32x4 (&acc)[4][4], int row0, int col0, int fr, int fq) const {
        const int blk = col0 >> 9, cc0 = col0 & 511;
        bf16* dst = (bf16*)(ws + (blk == 0 ? WS_KB : blk == 1 ? WS_VB : blk == 2 ? WS_UB : blk == 3 ? WS_VG : WS_QB));
#pragma unroll
        for (int m = 0; m < 4; ++m) {
            const int r = row0 + m * 16 + fr;
            if (blk == 0 || blk == 4) {
                if (r < TX) rope_tile<16>(acc[m], r & (SEQ - 1), 0, fq);
                if (blk == 4) {
#pragma unroll
                    for (int n = 0; n < 4; ++n) acc[m][n] = acc[m][n] * (DIFF_SCALE * LOG2E); }
            } else if (blk == 2 || blk == 3) {
#pragma unroll
                for (int n = 0; n < 4; ++n) { acc[m][n].x = gelu_(acc[m][n].x); acc[m][n].y = gelu_(acc[m][n].y); acc[m][n].z = gelu_(acc[m][n].z); acc[m][n].w = gelu_(acc[m][n].w); }
            }
#pragma unroll
            for (int n = 0; n < 4; ++n) *(u32x2*)(dst + (size_t)r * 512 + cc0 + n * 16 + fq * 4) = pk4(acc[m][n]);
        }
    }
};
struct EpiOdd {
    unsigned char* ws; const float* LB;
    DEVI void operator()(f32x4 (&acc)[4][4], int row0, int col0, int fr, int fq) const {
        const int blk = col0 >> 9, cc0 = col0 & 511;
        f32x4 lbv[4];
#pragma unroll
        for (int n = 0; n < 4; ++n) lbv[n] = *(const f32x4*)(LB + cc0 + n * 16 + fq * 4);
#pragma unroll
        for (int m = 0; m < 4; ++m) {
            const int r = row0 + m * 16 + fr;
            if (blk <= 1) {
                float* LF = (float*)(ws + WS_LF) + ((size_t)blk * T + r) * 512 + cc0;
#pragma unroll
                for (int n = 0; n < 4; ++n) { const f32x4 lb = lbv[n]; f32x4 o;
                    o.x = __logf(lb.x + (1.f - lb.x) * sigmoid_(acc[m][n].x)); o.y = __logf(lb.y + (1.f - lb.y) * sigmoid_(acc[m][n].y));
                    o.z = __logf(lb.z + (1.f - lb.z) * sigmoid_(acc[m][n].z)); o.w = __logf(lb.w + (1.f - lb.w) * sigmoid_(acc[m][n].w));
                    *(f32x4*)(LF + n * 16 + fq * 4) = o; }
            } else {
                bf16* dst; float sc = 1.f;
                switch (blk) {
                case 2: dst = (bf16*)(ws + WS_VS) + (size_t)r * 1024 + cc0; break;
                case 3: dst = (bf16*)(ws + WS_KR) + (size_t)r * 512 + cc0; sc = HEAD_SCALE; break;
                case 4: dst = (bf16*)(ws + WS_VS) + (size_t)r * 1024 + 512 + cc0; break;
                case 5: dst = (bf16*)(ws + WS_QS) + (size_t)r * 1024 + cc0; sc = HEAD_SCALE; break;
                case 6: dst = (bf16*)(ws + WS_G) + (size_t)r * 1024 + cc0; break;
                case 7: dst = (bf16*)(ws + WS_QS) + (size_t)r * 1024 + 512 + cc0; break;
                default: dst = (bf16*)(ws + WS_G) + (size_t)r * 1024 + 512 + cc0; break;
                }
                if (blk == 5) {
#pragma unroll
                    for (int n = 0; n < 4; ++n) { acc[m][n].x = silu_(acc[m][n].x); acc[m][n].y = silu_(acc[m][n].y); acc[m][n].z = silu_(acc[m][n].z); acc[m][n].w = silu_(acc[m][n].w); } }
#pragma unroll
                for (int n = 0; n < 4; ++n) *(u32x2*)(dst + ((blk == 3 || blk == 7) ? (n & 1) * 32 + (n >> 1) * 16 : n * 16) + fq * 4) = pk4(acc[m][n] * sc);
            }
        }
    }
};
struct EpiResid {
    bf16* XA; const float* gate; bf16* Hn; const float* ng; const float* sc; float* RSS;
    DEVI void operator()(f32x4 (&acc)[4][4], int row0, int col0, int fr, int fq) const {
        const int mi = mod_index(row0); const float* g = gate + (size_t)mi * 6144 + col0 + fq * 4; const float* s2 = sc + (size_t)mi * 6144 + col0 + fq * 4;
        float ss[4] = {0.f, 0.f, 0.f, 0.f};
        u32x2 xin[4][4]; f32x4 gvv[4], gmv[4];
#pragma unroll
        for (int n = 0; n < 4; ++n) { gvv[n] = *(const f32x4*)(g + n * 16); gmv[n] = *(const f32x4*)(ng + col0 + fq * 4 + n * 16) * (*(const f32x4*)(s2 + n * 16) + 1.f);
#pragma unroll
            for (int m = 0; m < 4; ++m) xin[n][m] = *(const u32x2*)(XA + (size_t)(row0 + m * 16 + fr) * 1024 + col0 + n * 16 + fq * 4); }
#pragma unroll
        for (int n = 0; n < 4; ++n) { const f32x4 gv = gvv[n]; const f32x4 gam = gmv[n];
#pragma unroll
            for (int m = 0; m < 4; ++m) { const size_t o = (size_t)(row0 + m * 16 + fr) * 1024 + col0 + n * 16 + fq * 4; u32x2* xp = (u32x2*)(XA + o); const u32x2 xo = xin[n][m]; const f32x4 x = (f32x4){bflo(xo.x), bfhi(xo.x), bflo(xo.y), bfhi(xo.y)} + gv * acc[m][n]; *xp = pk4(x);
                *(u32x2*)(Hn + o) = pk4(x * gam); ss[m] += x.x * x.x + x.y * x.y + x.z * x.z + x.w * x.w; } }
#pragma unroll
        for (int m = 0; m < 4; ++m) { float v = ss[m]; v += swz_xor<16>(v); v = x32_sum(v); if (fq == 0) RSS[(size_t)(row0 + m * 16 + fr) * 16 + (col0 >> 6)] = v; }
    }
};
struct EpiBf16Out {
    bf16* O; int ld; const float* RSS; const float* shq;
    DEVI void operator()(f32x4 (&acc)[4][4], int row0, int col0, int fr, int fq) const {
        const float* sq = shq + (size_t)mod_index(row0) * 2048 + col0 + fq * 4;
        float rs[4]; f32x4 sv[4];
#pragma unroll
        for (int m = 0; m < 4; ++m) { rs[m] = rss_rstd(RSS + (size_t)(row0 + m * 16 + fr) * 16); sv[m] = *(const f32x4*)(sq + m * 16); }
#pragma unroll
        for (int m = 0; m < 4; ++m)
#pragma unroll
            for (int n = 0; n < 4; ++n) *(u32x2*)(O + (size_t)(row0 + m * 16 + fr) * ld + col0 + n * 16 + fq * 4) = pk4(acc[m][n] * rs[m] + sv[n]);
    }
};

typedef float f32x16 __attribute__((ext_vector_type(16)));
typedef short s16x4 __attribute__((ext_vector_type(4)));
#define KSWZ(row, colB) ((row) * 256 + ((colB) ^ ((((row) & 7) << 4) | ((((row) >> 3) & 1) << 7))))
#define SBAR() __builtin_amdgcn_sched_barrier(0)
constexpr int SHM_V = 64 * 128 * 2, SHM_K = 64 * 128 * 2;
constexpr float ATT_THR = 8.f;
DEVI int crow(int r, int hi) { return (r & 3) + 8 * (r >> 2) + 4 * hi; }
DEVI unsigned cvtpk(float lo, float hi) { unsigned r; asm volatile("v_cvt_pk_bf16_f32 %0, %1, %2" : "=v"(r) : "v"(lo), "v"(hi)); return r; }
DEVI bf16 f2bf_hw(float x) { return __builtin_bit_cast(unsigned short, (__bf16)x); }
DEVI void partialSM(f32x16& p0, f32x16& p1, float& m_reg, float& mn, float& alpha) {
    float pmax = p0[0];
#pragma unroll
    for (int r = 1; r < 16; ++r) pmax = fmaxf(pmax, p0[r]);
#pragma unroll
    for (int r = 0; r < 16; ++r) pmax = fmaxf(pmax, p1[r]);
    { auto rr = __builtin_amdgcn_permlane32_swap(__float_as_uint(pmax), __float_as_uint(pmax), false, false);
      pmax = fmaxf(__uint_as_float(rr[0]), __uint_as_float(rr[1])); }
    if (__builtin_expect(__all(pmax - m_reg <= ATT_THR), 1)) { mn = m_reg; alpha = 1.f; }
    else { mn = fmaxf(m_reg, pmax); alpha = __builtin_amdgcn_exp2f(m_reg - mn); m_reg = mn; }
#pragma unroll
    for (int r = 0; r < 16; ++r) { p0[r] -= mn; p1[r] -= mn; }
#pragma unroll
    for (int r = 0; r < 16; ++r) p0[r] = __builtin_amdgcn_exp2f(p0[r]);
}
DEVI void finishSM(f32x16& p0, f32x16& p1, float alpha, float& l_reg, bf16x8& pa0, bf16x8& pa1, bf16x8& pa2, bf16x8& pa3) {
#pragma unroll
    for (int r = 0; r < 16; ++r) p1[r] = __builtin_amdgcn_exp2f(p1[r]);
    float ps = 0.f;
#pragma unroll
    for (int r = 0; r < 16; ++r) ps += p0[r];
#pragma unroll
    for (int r = 0; r < 16; ++r) ps += p1[r];
    { auto rr = __builtin_amdgcn_permlane32_swap(__float_as_uint(ps), __float_as_uint(ps), false, false);
      ps = __uint_as_float(rr[0]) + __uint_as_float(rr[1]); }
    l_reg = l_reg * alpha + ps;
#define PK4(P, BASE, OUT) do { unsigned a0 = cvtpk(P[BASE + 0], P[BASE + 1]), a1 = cvtpk(P[BASE + 2], P[BASE + 3]);   \
    unsigned b0 = cvtpk(P[BASE + 4], P[BASE + 5]), b1 = cvtpk(P[BASE + 6], P[BASE + 7]);                              \
    auto r0 = __builtin_amdgcn_permlane32_swap(a0, b0, false, false); auto r1 = __builtin_amdgcn_permlane32_swap(a1, b1, false, false); \
    u32x4 w = {r0[0], r1[0], r0[1], r1[1]}; OUT = *reinterpret_cast<bf16x8*>(&w); } while (0)
    PK4(p0, 0, pa0); PK4(p0, 8, pa1); PK4(p1, 0, pa2); PK4(p1, 8, pa3);
#undef PK4
}
DEVI void qkt(f32x16& p0, f32x16& p1, const unsigned char* Ks, const bf16x8* qr, int r32, int hi, int cb0) {
    p0 = f32x16{}; p1 = f32x16{};
#pragma unroll
    for (int d0 = 0; d0 < 4; ++d0) { const int cb = cb0 + (d0 * 16 + hi * 8) * 2;
        const bf16x8 b0 = *reinterpret_cast<const bf16x8*>(Ks + KSWZ(r32, cb));
        const bf16x8 b1 = *reinterpret_cast<const bf16x8*>(Ks + KSWZ(32 + r32, cb));
        p0 = __builtin_amdgcn_mfma_f32_32x32x16_bf16(b0, qr[d0], p0, 0, 0, 0);
        p1 = __builtin_amdgcn_mfma_f32_32x32x16_bf16(b1, qr[d0], p1, 0, 0, 0); }
}
DEVI int v_st(int k, int c) { const int kk = (k & ~0xC) | ((k & 4) << 1) | ((k & 8) >> 1); return ((kk >> 3) * 4 + (c >> 5)) * 512 + ((kk & 7) * 32 + (c & 31)) * 2; }
DEVI int v_rd_base(int lane) { return ((lane & 3) << 3) | (((lane >> 2) & 3) << 6) | (((lane >> 4) & 1) << 5) | (((lane >> 5) & 1) << 8); }
constexpr int v_rd_off(int d0, int ks, int half) { return d0 * 512 + ks * 4096 + half * 2048; }
template <int OFF> DEVI s16x4 tr_read(int vb) { s16x4 r; asm volatile("ds_read_b64_tr_b16 %0, %1 offset:%2" : "=&v"(r) : "v"(vb), "i"(OFF) : "memory"); return r; }
template <int D0> DEVI void pv_one(f32x16& od, int vb, bf16x8 pa0, bf16x8 pa1, bf16x8 pa2, bf16x8 pa3) {
    const s16x4 l0 = tr_read<v_rd_off(D0, 0, 0)>(vb), h0 = tr_read<v_rd_off(D0, 0, 1)>(vb), l1 = tr_read<v_rd_off(D0, 1, 0)>(vb), h1 = tr_read<v_rd_off(D0, 1, 1)>(vb);
    const s16x4 l2 = tr_read<v_rd_off(D0, 2, 0)>(vb), h2 = tr_read<v_rd_off(D0, 2, 1)>(vb), l3 = tr_read<v_rd_off(D0, 3, 0)>(vb), h3 = tr_read<v_rd_off(D0, 3, 1)>(vb);
    asm volatile("s_waitcnt lgkmcnt(0)" ::: "memory"); SBAR();
#define PKV(L, H) (bf16x8){L[0], L[1], L[2], L[3], H[0], H[1], H[2], H[3]}
    od = __builtin_amdgcn_mfma_f32_32x32x16_bf16(pa0, PKV(l0, h0), od, 0, 0, 0);
    od = __builtin_amdgcn_mfma_f32_32x32x16_bf16(pa1, PKV(l1, h1), od, 0, 0, 0);
    od = __builtin_amdgcn_mfma_f32_32x32x16_bf16(pa2, PKV(l2, h2), od, 0, 0, 0);
    od = __builtin_amdgcn_mfma_f32_32x32x16_bf16(pa3, PKV(l3, h3), od, 0, 0, 0);
#undef PKV
}
#define LW8(N, a) asm volatile("s_waitcnt lgkmcnt(" #N ")" : "+v"(a[0]), "+v"(a[1]), "+v"(a[2]), "+v"(a[3]), "+v"(a[4]), "+v"(a[5]), "+v"(a[6]), "+v"(a[7]) :: "memory")
template <int D0> DEVI void v_read8(s16x4* v, int vb) {
    v[0] = tr_read<v_rd_off(D0, 0, 0)>(vb); v[1] = tr_read<v_rd_off(D0, 0, 1)>(vb); v[2] = tr_read<v_rd_off(D0, 1, 0)>(vb); v[3] = tr_read<v_rd_off(D0, 1, 1)>(vb);
    v[4] = tr_read<v_rd_off(D0, 2, 0)>(vb); v[5] = tr_read<v_rd_off(D0, 2, 1)>(vb); v[6] = tr_read<v_rd_off(D0, 3, 0)>(vb); v[7] = tr_read<v_rd_off(D0, 3, 1)>(vb);
}
DEVI void pv4(f32x16& od, const s16x4* v, bf16x8 pa0, bf16x8 pa1, bf16x8 pa2, bf16x8 pa3) {
#define PKV(L, H) (bf16x8){L[0], L[1], L[2], L[3], H[0], H[1], H[2], H[3]}
    od = __builtin_amdgcn_mfma_f32_32x32x16_bf16(pa0, PKV(v[0], v[1]), od, 0, 0, 0);
    od = __builtin_amdgcn_mfma_f32_32x32x16_bf16(pa1, PKV(v[2], v[3]), od, 0, 0, 0);
    od = __builtin_amdgcn_mfma_f32_32x32x16_bf16(pa2, PKV(v[4], v[5]), od, 0, 0, 0);
    od = __builtin_amdgcn_mfma_f32_32x32x16_bf16(pa3, PKV(v[6], v[7]), od, 0, 0, 0);
#undef PKV
}
DEVI void pv_d0(f32x16* o, int vb, bf16x8 pa0, bf16x8 pa1, bf16x8 pa2, bf16x8 pa3) {
    s16x4 va[8], vc[8];
    v_read8<0>(va, vb); v_read8<1>(vc, vb);
    LW8(8, va); SBAR(); pv4(o[0], va, pa0, pa1, pa2, pa3); SBAR();
    v_read8<2>(va, vb);
    LW8(8, vc); SBAR(); pv4(o[1], vc, pa0, pa1, pa2, pa3); SBAR();
    v_read8<3>(vc, vb);
    LW8(8, va); SBAR(); pv4(o[2], va, pa0, pa1, pa2, pa3); SBAR();
    LW8(0, vc); SBAR(); pv4(o[3], vc, pa0, pa1, pa2, pa3);
}
DEVI void attn_unit(const Params& p, int jl, int b, int h, int q0row, int nxt, int NT, unsigned char* lds, float lam, float lam_init) {
    const int tid = tidx(), wid = tid >> 6, lane = tid & 63, r32 = lane & 31, hi = lane >> 5, rg = wid >> 1, st = wid & 1;
    const bf16* QB = (const bf16*)(p.ws + WS_QB); const bf16* KB = (const bf16*)(p.ws + WS_KB); const bf16* VB = (const bf16*)(p.ws + WS_VB); bf16* OX = (bf16*)(p.ws + WS_OX);
    unsigned char* V_lds = lds; unsigned char* K_lds = lds + 2 * SHM_V;
    float* wsl = (float*)(lds + 2 * SHM_V + 2 * SHM_K) + wid * 64; float* li_l = wsl; float* al_l = wsl + 32;
    float m_reg = -1e30f, l_reg = 0.f; f32x16 o[4] = {}; bf16x8 qr[4];
    { const bf16* Qw = QB + (size_t)(q0row + rg * 32 + r32) * 512 + h * 128 + st * 64 + hi * 8;
#pragma unroll
      for (int d0 = 0; d0 < 4; ++d0) qr[d0] = *reinterpret_cast<const bf16x8*>(Qw + d0 * 16); }
    const int cb0 = st * 128;
    const int sr = tid >> 4, sc = (tid & 15) * 8, vst0 = v_st(sr, sc), vst1 = v_st(32 + sr, sc);
    const int vb0 = (int)(uintptr_t)V_lds + v_rd_base(lane);
    const bf16* Kx = KB + (size_t)(b * SEQ) * 512 + h * 128; const bf16* Kc = KB + (size_t)(TX + b * NCTX) * 512 + h * 128;
    const bf16* Vx = VB + (size_t)(b * SEQ) * 512 + h * 128; const bf16* Vc = VB + (size_t)(TX + b * NCTX) * 512 + h * 128;
    struct { bf16x8 vs0, vs1, ks0, ks1; } sr_[2];
#define TROW(j) ((j) < nxt ? (size_t)(j) * 64 : (size_t)((j) - nxt) * 64)
#define SLOAD(i, j) do { const bool inx_ = (j) < nxt; const bf16* Kh_ = (inx_ ? Kx : Kc) + TROW(j) * 512; const bf16* Vh_ = (inx_ ? Vx : Vc) + TROW(j) * 512; \
    sr_[i].vs0 = *(const bf16x8*)(Vh_ + (size_t)sr * 512 + sc); sr_[i].vs1 = *(const bf16x8*)(Vh_ + (size_t)(32 + sr) * 512 + sc); \
    sr_[i].ks0 = *(const bf16x8*)(Kh_ + (size_t)sr * 512 + sc); sr_[i].ks1 = *(const bf16x8*)(Kh_ + (size_t)(32 + sr) * 512 + sc); } while (0)
#define SWRITE(bb, i) do { *(bf16x8*)(V_lds + (bb) * SHM_V + vst0) = sr_[i].vs0; *(bf16x8*)(V_lds + (bb) * SHM_V + vst1) = sr_[i].vs1; const int kc = sc * 2; \
    *(bf16x8*)(K_lds + (bb) * SHM_K + KSWZ(sr, kc)) = sr_[i].ks0; *(bf16x8*)(K_lds + (bb) * SHM_K + KSWZ(32 + sr, kc)) = sr_[i].ks1; } while (0)
#define SWAIT() asm volatile("s_waitcnt vmcnt(4)" ::: "memory")
#define RESC(a) do { if (__any((a) < 1.f)) { if (hi == 0) al_l[r32] = (a); asm volatile("s_waitcnt lgkmcnt(0)" ::: "memory"); \
    _Pragma("unroll") for (int d = 0; d < 4; ++d) _Pragma("unroll") for (int r = 0; r < 16; ++r) o[d][r] *= al_l[crow(r, hi)]; } } while (0)
    f32x16 pA0, pA1, pB0, pB1; float mnA, mnB, alA, alB; bf16x8 pa0, pa1, pa2, pa3;
    constexpr int SE = 0, SO = 1;
    __syncthreads();
    SLOAD(SE, 0); asm volatile("s_waitcnt vmcnt(0)" ::: "memory"); SWRITE(0, SE); __syncthreads();
    qkt(pA0, pA1, K_lds, qr, r32, hi, cb0); partialSM(pA0, pA1, m_reg, mnA, alA);
    SLOAD(SO, 1); if (2 < NT) SLOAD(SE, 2);
    SWAIT(); SWRITE(1, SO); __syncthreads();
    for (int j = 1; j + 1 < NT; j += 2) {
        SBAR(); qkt(pB0, pB1, K_lds + SHM_K, qr, r32, hi, cb0);
        finishSM(pA0, pA1, alA, l_reg, pa0, pa1, pa2, pa3); SBAR();
        SLOAD(SO, j + 2); SBAR();
        pv_d0(o, vb0, pa0, pa1, pa2, pa3); partialSM(pB0, pB1, m_reg, mnB, alB);
        __syncthreads(); SWAIT(); SWRITE(0, SE);
        RESC(alB); __syncthreads();
        SBAR(); qkt(pA0, pA1, K_lds, qr, r32, hi, cb0);
        finishSM(pB0, pB1, alB, l_reg, pa0, pa1, pa2, pa3); SBAR();
        if (j + 3 < NT) SLOAD(SE, j + 3); SBAR();
        pv_d0(o, vb0 + SHM_V, pa0, pa1, pa2, pa3); partialSM(pA0, pA1, m_reg, mnA, alA);
        __syncthreads(); SWAIT(); SWRITE(1, SO);
        RESC(alA); __syncthreads();
    }
    SBAR(); qkt(pB0, pB1, K_lds + SHM_K, qr, r32, hi, cb0);
    finishSM(pA0, pA1, alA, l_reg, pa0, pa1, pa2, pa3); SBAR();
    pv_d0(o, vb0, pa0, pa1, pa2, pa3); partialSM(pB0, pB1, m_reg, mnB, alB);
    __syncthreads(); RESC(alB);
    finishSM(pB0, pB1, alB, l_reg, pa0, pa1, pa2, pa3); SBAR();
    pv_d0(o, vb0 + SHM_V, pa0, pa1, pa2, pa3);
    if (hi == 0) li_l[r32] = l_reg;
    asm volatile("s_waitcnt lgkmcnt(0)" ::: "memory");
    float rli[16];
#pragma unroll
    for (int r = 0; r < 16; ++r) rli[r] = __builtin_amdgcn_rcpf(li_l[crow(r, hi)]);
    __syncthreads();
    float* X = (float*)lds + rg * (32 * 128);
    if (st == 1) {
#pragma unroll
        for (int r = 0; r < 16; ++r)
#pragma unroll
            for (int d0 = 0; d0 < 4; ++d0) X[crow(r, hi) * 128 + d0 * 32 + r32] = o[d0][r] * rli[r] * lam;
    }
    __syncthreads();
    if (st == 0) {
        float ss[16];
#pragma unroll
        for (int r = 0; r < 16; ++r) { float s2 = 0.f;
#pragma unroll
            for (int d0 = 0; d0 < 4; ++d0) { const float v = o[d0][r] * rli[r] - X[crow(r, hi) * 128 + d0 * 32 + r32]; o[d0][r] = v; s2 += v * v; }
            ss[r] = s2; }
#pragma unroll
        for (int r = 0; r < 16; ++r) ss[r] = half_sum(ss[r]);
        float gn[4];
#pragma unroll
        for (int d0 = 0; d0 < 4; ++d0) gn[d0] = p.diff_sub_gain[jl * 128 + d0 * 32 + r32] * (1.f - lam_init);
#pragma unroll
        for (int r = 0; r < 16; ++r) { const float rn = rsqrtf(ss[r] * (1.f / 128.f) + EPS); bf16* orow = OX + (size_t)(q0row + rg * 32 + crow(r, hi)) * 1024 + 512 + h * 128 + r32;
#pragma unroll
            for (int d0 = 0; d0 < 4; ++d0) orow[d0 * 32] = (bf16)f2bf(o[d0][r] * rn * gn[d0]); }
    }
#undef TROW
#undef SLOAD
#undef SWRITE
#undef SWAIT
#undef RESC
}
DEVI void ph_attn(const Params& p, int layer, unsigned char* lds) {
    const int jl = layer >> 1; const float lam = ((const float*)(p.ws + WS_LAM))[jl], lam_init = jl == 0 ? 0.2f : 0.47071301834f;
    const int G = gridDim.x, nloc = G >> 3, xcd = blockIdx.x & 7, loc = blockIdx.x >> 3, b = xcd >> 2, h = xcd & 3;
    for (int u = loc; u < 66; u += nloc) {
        if (u < 64) attn_unit(p, jl, b, h, b * SEQ + u * 128, 128, NCHUNK, lds, lam, lam_init);
        else attn_unit(p, jl, b, h, TX + b * NCTX + (u - 64) * 128, 0, 4, lds, lam, lam_init);
    }
}

typedef float f32x16v __attribute__((ext_vector_type(16)));
typedef float f32x32v __attribute__((ext_vector_type(32)));
typedef unsigned u32x6 __attribute__((ext_vector_type(6)));
constexpr size_t TAB_V = 12 * MiB, TAB_SCL = 24 * MiB;
constexpr int TAB_SEL = 4096;
DEVI void ph_tables(const Params& p, int layer, int b0, int nb, bool pf, int rp0, int rp1) {
    if ((int)blockIdx.x < b0 || (int)blockIdx.x >= b0 + nb) return;
    const int tid = tidx(), lane = tid & 63, g = lane & 31, hf = lane >> 5, gw = ((int)blockIdx.x - b0) * NWV + (tid >> 6), NW = nb * NWV;
    float* SCL = (float*)(p.ws + WS_TAB + TAB_SCL);
    f32x4 xn[8];
#define TAB_SRC(rp_) ((const f32x4*)(((((2 * (rp_) + hf) >> 14) ? p.peer_v : p.peer_u)) + ((size_t)layer * 16384 + ((2 * (rp_) + hf) & 16383)) * 1024 + 32 * g))
    if (rp0 + gw < rp1) { const f32x4* s0 = TAB_SRC(rp0 + gw);
#pragma unroll
        for (int i = 0; i < 8; ++i) xn[i] = s0[i]; }
    for (int rp = rp0 + gw; rp < rp1; rp += NW) {
        const int row = 2 * rp + hf, tab = row >> 14, e = row & 16383;
        f32x4 x[8]; float am = 0.f;
#pragma unroll
        for (int i = 0; i < 8; ++i) { x[i] = xn[i]; am = fmaxf(am, fmaxf(fmaxf(fabsf(x[i].x), fabsf(x[i].y)), fmaxf(fabsf(x[i].z), fabsf(x[i].w)))); }
        if (pf && rp + NW < rp1) { const f32x4* s1 = TAB_SRC(rp + NW);
#pragma unroll
            for (int i = 0; i < 8; ++i) xn[i] = s1[i]; }
        am = half_max(am);
        const float e2 = am > 0.f ? floorf(log2f(7.5f / am)) : 0.f; const float sc = exp2f(e2);
        f32x16v a, bb;
#pragma unroll
        for (int i = 0; i < 8; ++i) { a[2 * i] = x[i].x * sc; bb[2 * i] = x[i].y * sc; a[2 * i + 1] = x[i].z * sc; bb[2 * i + 1] = x[i].w * sc; }
        const u32x6 w = __builtin_amdgcn_cvt_scalef32_2xpk16_fp6_f32(a, bb, 1.0f);
        unsigned char* dst = p.ws + WS_TAB + (size_t)tab * TAB_V + (size_t)e * 768 + 8 * g;
        *(u32x2*)dst = (u32x2){w[0], w[1]}; *(u32x2*)(dst + 256) = (u32x2){w[2], w[3]}; *(u32x2*)(dst + 512) = (u32x2){w[4], w[5]};
        if (g == 0) SCL[row] = exp2f(-e2);
        if (!pf && rp + NW < rp1) { const f32x4* s1 = TAB_SRC(rp + NW);
#pragma unroll
            for (int i = 0; i < 8; ++i) xn[i] = s1[i]; }
    }
#undef TAB_SRC
}
#define GAS __attribute__((address_space(1)))
DEVI u32x2 gld8(const unsigned char* p) { return *(const GAS u32x2*)p; }
DEVI float gelu_fast(float x) { const float u = 1.5957691216057308f * (x + 0.044715f * x * x * x); return x * __builtin_amdgcn_rcpf(1.f + __expf(-u)); }
#if defined(PROF_STEP)
#define GNJ 1
#else
#define GNJ 2
#endif
template <bool DRY> DEVI void ph_peer_gather(const Params& p, int layer, float* smem) {
    const bf16* H = (const bf16*)(p.ws + WS_H); bf16* XA = (bf16*)(p.ws + WS_XA); const int* EID = (const int*)(p.ws + WS_EID); const float* GATE = (const float*)(p.ws + WS_GATE);
    const float* MOD = (const float*)(p.ws + WS_MOD);
    const unsigned char* TU = p.ws + WS_TAB; const unsigned char* TV = p.ws + WS_TAB + TAB_V; const float* SCL = (const float*)(p.ws + WS_TAB + TAB_SCL);
    const int tid = tidx(), lane = tid & 63, g = lane & 31, hf = lane >> 5, gw = blockIdx.x * NWV + (tid >> 6), NW = gridDim.x * NWV, nrow = layer == DEPTH - 1 ? TX : T;
    const bool last = layer == DEPTH - 1;
    const int nmain = (nrow / NW) * NW, ntail = nrow - nmain, split = (ntail > 0 && ntail * 4 == NW) ? 1 : 0, nitem = nmain / NW + (ntail > 0 ? 1 : 0);
    for (int itx = 0; itx < nitem; ++itx) {
        const bool tailq = split && itx == nmain / NW;
        const int r = tailq ? nmain + (gw >> 2) : gw + itx * NW; const int s0 = tailq ? (gw & 3) * 32 : 0, s1 = tailq ? s0 + 32 : 128;
        if (!tailq && r >= nrow) continue;
        float hv[32];
        { const u32x4* hp = (const u32x4*)(H + (size_t)r * 1024 + 32 * g); const float rs2 = rss_rstd((const float*)(p.ws + WS_RSS) + ((size_t)layer * T + r) * 16);
          const float* sh2 = MOD + (size_t)(layer * 3 + mod_index(r)) * 6144 + 3072 + 32 * g;
#pragma unroll
          for (int i = 0; i < 4; ++i) { const u32x4 a = hp[i]; const f32x4 s0 = *(const f32x4*)(sh2 + 8 * i), s1 = *(const f32x4*)(sh2 + 8 * i + 4);
              hv[8 * i] = bflo(a.x) * rs2 + s0.x; hv[8 * i + 1] = bfhi(a.x) * rs2 + s0.y; hv[8 * i + 2] = bflo(a.y) * rs2 + s0.z; hv[8 * i + 3] = bfhi(a.y) * rs2 + s0.w;
              hv[8 * i + 4] = bflo(a.z) * rs2 + s1.x; hv[8 * i + 5] = bfhi(a.z) * rs2 + s1.y; hv[8 * i + 6] = bflo(a.w) * rs2 + s1.z; hv[8 * i + 7] = bfhi(a.w) * rs2 + s1.w; } }
        f32x2 hv2[16], acc2[16];
#pragma unroll
        for (int i = 0; i < 16; ++i) { hv2[i] = (f32x2){hv[2 * i], hv[2 * i + 1]}; acc2[i] = (f32x2){0.f, 0.f}; }
        const int E0 = EID[(size_t)r * 128 + lane], E1 = EID[(size_t)r * 128 + 64 + lane];
        const float G0 = GATE[(size_t)r * 128 + lane], G1 = GATE[(size_t)r * 128 + 64 + lane];
        u32x2 uA[GNJ][3], vA[GNJ][3], uB[GNJ][3], vB[GNJ][3]; float guA[GNJ], gvA[GNJ], guB[GNJ], gvB[GNJ];
#define G_LOAD(UU, VV, GU, GV, e0_) do { _Pragma("unroll") for (int j = 0; j < GNJ; ++j) { const int sl = (e0_) + 2 * j, li = sl & 63; const int Es = sl < 64 ? E0 : E1; const float Gs = sl < 64 ? G0 : G1; \
            const int ea = __builtin_amdgcn_readlane(Es, li), eb = __builtin_amdgcn_readlane(Es, li + 1); const float ga = __builtin_bit_cast(float, __builtin_amdgcn_readlane(__builtin_bit_cast(int, Gs), li)), gb = __builtin_bit_cast(float, __builtin_amdgcn_readlane(__builtin_bit_cast(int, Gs), li + 1)); \
            const int eid = hf ? eb : ea; GU[j] = SCL[eid]; GV[j] = (hf ? gb : ga) * SCL[16384 + eid]; \
            const unsigned roff = (unsigned)eid * 768u + 8u * (unsigned)g; \
            _Pragma("unroll") for (int w = 0; w < 3; ++w) { UU[j][w] = gld8(TU + (roff + 256u * w)); VV[j][w] = gld8(TV + (roff + 256u * w)); } } } while (0)
#define G_USE(UU, VV, GU, GV) do { _Pragma("unroll") for (int j = 0; j < GNJ; ++j) { \
            const f32x32v fu = __builtin_amdgcn_cvt_scalef32_pk32_f32_fp6((u32x6){UU[j][0].x, UU[j][0].y, UU[j][1].x, UU[j][1].y, UU[j][2].x, UU[j][2].y}, 1.0f); \
            f32x2 dA = {0.f, 0.f}, dB = {0.f, 0.f}; _Pragma("unroll") for (int i = 0; i < 16; i += 2) { dA += hv2[i] * (f32x2){fu[2 * i], fu[2 * i + 1]}; dB += hv2[i + 1] * (f32x2){fu[2 * i + 2], fu[2 * i + 3]}; } \
            float d = row16_sum((dA.x + dA.y) + (dB.x + dB.y)); d += swz_xor<16>(d); \
            const float coef = GV[j] * gelu_fast(d * GU[j]); \
            const f32x32v fv = __builtin_amdgcn_cvt_scalef32_pk32_f32_fp6((u32x6){VV[j][0].x, VV[j][0].y, VV[j][1].x, VV[j][1].y, VV[j][2].x, VV[j][2].y}, 1.0f); \
            _Pragma("unroll") for (int i = 0; i < 16; ++i) acc2[i] += (f32x2){fv[2 * i], fv[2 * i + 1]} * coef; } } while (0)
        G_LOAD(uA, vA, guA, gvA, s0);
        for (int e0 = s0; e0 < s1; e0 += 4 * GNJ) {
            G_LOAD(uB, vB, guB, gvB, e0 + 2 * GNJ);
            G_USE(uA, vA, guA, gvA);
            if (e0 + 4 * GNJ < s1) G_LOAD(uA, vA, guA, gvA, e0 + 4 * GNJ);
            G_USE(uB, vB, guB, gvB);
        }
#undef G_LOAD
#undef G_USE
        float o[16];
#pragma unroll
        for (int i = 0; i < 16; ++i) { const float lo = (i & 1) ? acc2[i >> 1].y : acc2[i >> 1].x, hi2 = (i & 1) ? acc2[8 + (i >> 1)].y : acc2[8 + (i >> 1)].x; const auto sw = __builtin_amdgcn_permlane32_swap(__float_as_uint(lo), __float_as_uint(hi2), false, false); o[i] = __uint_as_float(sw[0]) + __uint_as_float(sw[1]); }
        const int col0 = 32 * g + 16 * hf;
        if (tailq) {
            const int wq = gw & 3, wgp = (tid >> 6) >> 2; float* X = smem + (wgp * 4) * 1024;
            __syncthreads();
#pragma unroll
            for (int i = 0; i < 16; i += 4) *(f32x4*)(X + wq * 1024 + col0 + i) = (f32x4){o[i], o[i + 1], o[i + 2], o[i + 3]};
            __syncthreads();
            if (wq != 0) continue;
#pragma unroll
            for (int i = 0; i < 16; i += 4) { const f32x4 a = *(const f32x4*)(X + col0 + i), b2 = *(const f32x4*)(X + 1024 + col0 + i), c2 = *(const f32x4*)(X + 2048 + col0 + i), d2 = *(const f32x4*)(X + 3072 + col0 + i);
                o[i] = (a.x + b2.x) + (c2.x + d2.x); o[i + 1] = (a.y + b2.y) + (c2.y + d2.y); o[i + 2] = (a.z + b2.z) + (c2.z + d2.z); o[i + 3] = (a.w + b2.w) + (c2.w + d2.w); }
        }
        const float* g2 = MOD + (size_t)(layer * 3 + mod_index(r)) * 6144 + 5120 + col0;
        bf16* xr = XA + (size_t)r * 1024 + col0;
        f32x4 x[4];
        { const u32x4 xa = *(const u32x4*)xr, xb = *(const u32x4*)(xr + 8);
          x[0] = (f32x4){bflo(xa.x), bfhi(xa.x), bflo(xa.y), bfhi(xa.y)}; x[1] = (f32x4){bflo(xa.z), bfhi(xa.z), bflo(xa.w), bfhi(xa.w)};
          x[2] = (f32x4){bflo(xb.x), bfhi(xb.x), bflo(xb.y), bfhi(xb.y)}; x[3] = (f32x4){bflo(xb.z), bfhi(xb.z), bflo(xb.w), bfhi(xb.w)}; }
#pragma unroll
        for (int q = 0; q < 4; ++q) { const f32x4 gg = *(const f32x4*)(g2 + 4 * q);
            x[q].x += gg.x * o[q * 4 + 0]; x[q].y += gg.y * o[q * 4 + 1]; x[q].z += gg.z * o[q * 4 + 2]; x[q].w += gg.w * o[q * 4 + 3]; }
        float ss = 0.f;
#pragma unroll
        for (int q = 0; q < 4; ++q) ss += x[q].x * x[q].x + x[q].y * x[q].y + x[q].z * x[q].z + x[q].w * x[q].w;
        const float rstd = rsqrtf(wave_sum(ss) * (1.f / 1024.f) + EPS);
        if (DRY) { if (x[0].x == 1.2345e30f) xr[0] = f2bf_hw(x[1].x + x[2].y + x[3].z); }
        else if (!last) {
            const float* gN = p.norm_g + (layer + 1) * 2 * 1024 + col0; const float* mN = MOD + (size_t)((layer + 1) * 3 + mod_index(r)) * 6144 + col0;
            bf16* hr = (bf16*)(p.ws + WS_H) + (size_t)r * 1024 + col0;
#pragma unroll
            for (int q = 0; q < 4; ++q) { *(u32x2*)(xr + 4 * q) = pk4(x[q]);
                const f32x4 g4 = *(const f32x4*)(gN + 4 * q), sh = *(const f32x4*)(mN + 4 * q), sc = *(const f32x4*)(mN + 1024 + 4 * q);
                *(u32x2*)(hr + 4 * q) = pk4(x[q] * rstd * g4 * (sc + 1.f) + sh); }
        } else {
#pragma unroll
            for (int q = 0; q < 4; ++q) *(f32x4*)(p.out + (size_t)r * 1024 + col0 + 4 * q) = x[q] * rstd * *(const f32x4*)(p.final_g + col0 + 4 * q);
        }
    }
}


#if defined(PROF_GDRY)
DEVI void ph_gather_dry(const Params& p, int layer) {
    const int* EID = (const int*)(p.ws + WS_EID); float* XA = (float*)(p.ws + WS_XA);
    const unsigned char* TU = p.ws + WS_TAB; const unsigned char* TV = p.ws + WS_TAB + TAB_V;
    const int tid = tidx(), lane = tid & 63, gw = blockIdx.x * NWV + (tid >> 6), NW = gridDim.x * NWV, nrow = layer == DEPTH - 1 ? TX : T;
    for (int r = gw; r < nrow; r += NW) {
        unsigned sum = 0u;
#if PROF_GDRY == 1
        const int g = lane & 31, hf = lane >> 5; const int* er = EID + (size_t)r * 128 + hf;
        for (int e0 = 0; e0 < 128; e0 += 8) {
            u32x2 uu[4][3], vv[4][3];
#pragma unroll
            for (int j = 0; j < 4; ++j) { const int eid = er[e0 + 2 * j];
#pragma unroll
                for (int w = 0; w < 3; ++w) { uu[j][w] = *(const u32x2*)(TU + (size_t)eid * 768 + 8 * g + 256 * w); vv[j][w] = *(const u32x2*)(TV + (size_t)eid * 768 + 8 * g + 256 * w); } }
#pragma unroll
            for (int j = 0; j < 4; ++j)
#pragma unroll
                for (int w = 0; w < 3; ++w) sum += uu[j][w].x ^ uu[j][w].y ^ vv[j][w].x ^ vv[j][w].y;
        }
#elif PROF_GDRY == 2
        const int* er = EID + (size_t)r * 128;
        for (int e0 = 0; e0 < 128; e0 += 8) {
            u32x4 uu[8], vv[8];
#pragma unroll
            for (int j = 0; j < 8; ++j) { const int eid = __builtin_amdgcn_readfirstlane(er[e0 + j]); const int l = lane < 48 ? lane : 47;
                uu[j] = *(const u32x4*)(TU + (size_t)eid * 768 + 16 * l); vv[j] = *(const u32x4*)(TV + (size_t)eid * 768 + 16 * l); }
#pragma unroll
            for (int j = 0; j < 8; ++j) sum += uu[j].x ^ uu[j].y ^ uu[j].z ^ uu[j].w ^ vv[j].x ^ vv[j].y ^ vv[j].z ^ vv[j].w;
        }
#else
        const int t16 = lane & 15, q = lane >> 4; const int* er = EID + (size_t)r * 128 + q;
        for (int e0 = 0; e0 < 128; e0 += 16) {
            u32x4 uu[4][3], vv[4][3];
#pragma unroll
            for (int j = 0; j < 4; ++j) { const int eid = er[e0 + 4 * j];
#pragma unroll
                for (int w = 0; w < 3; ++w) { uu[j][w] = *(const u32x4*)(TU + (size_t)eid * 768 + 16 * t16 + 256 * w); vv[j][w] = *(const u32x4*)(TV + (size_t)eid * 768 + 16 * t16 + 256 * w); } }
#pragma unroll
            for (int j = 0; j < 4; ++j)
#pragma unroll
                for (int w = 0; w < 3; ++w) sum += uu[j][w].x ^ uu[j][w].y ^ uu[j][w].z ^ uu[j][w].w ^ vv[j][w].x ^ vv[j][w].y ^ vv[j][w].z ^ vv[j][w].w;
        }
#endif
        if (sum == 0x12345677u) XA[(size_t)r * 1024 + lane] = 0.f;
    }
}
#endif
DEVI void ph_peer_select(const Params& p, int layer, float* smem) {
    const bf16* QP = (const bf16*)(p.ws + WS_QP); const bf16* SKB = (const bf16*)(p.ws + WT_SK) + (size_t)layer * 16 * 128 * 128;
    int* EID = (int*)(p.ws + WS_EID); float* GATE = (float*)(p.ws + WS_GATE);
    const int tid = tidx(), wid = tid >> 6, lane = tid & 63, fr = lane & 15, fq = lane >> 4;
    const int nblk = layer == DEPTH - 1 ? TX / 128 : T / 128;
    constexpr int LS = 129;
    float* SCL = smem;
    for (int it = blockIdx.x; it < nblk * 8; it += gridDim.x) {
        const int tb = it >> 3, h = it & 7, r0 = tb * 128;
        {
            const int pp = wid & 1, tg = wid >> 1;
            const bf16* Aq = SKB + ((size_t)(h * 2 + pp) * 128) * 128; const bf16* Bq = QP + (size_t)(r0 + tg * 32) * 2048 + h * 256 + pp * 128;
            f32x4 acc[8][2];
#pragma unroll
            for (int a = 0; a < 8; ++a) { acc[a][0] = (f32x4){0.f, 0.f, 0.f, 0.f}; acc[a][1] = (f32x4){0.f, 0.f, 0.f, 0.f}; }
#pragma unroll
            for (int ks = 0; ks < 4; ++ks) {
                bf16x8 bfr[2], afr[8];
#pragma unroll
                for (int n = 0; n < 2; ++n) bfr[n] = *(const bf16x8*)(Bq + (size_t)(n * 16 + fr) * 2048 + ks * 32 + fq * 8);
#pragma unroll
                for (int m = 0; m < 8; ++m) afr[m] = *(const bf16x8*)(Aq + (size_t)(m * 16 + fr) * 128 + ks * 32 + fq * 8);
#pragma unroll
                for (int m = 0; m < 8; ++m)
#pragma unroll
                    for (int n = 0; n < 2; ++n) acc[m][n] = __builtin_amdgcn_mfma_f32_16x16x32_bf16(afr[m], bfr[n], acc[m][n], 0, 0, 0);
            }
            __syncthreads();
#pragma unroll
            for (int m = 0; m < 8; ++m)
#pragma unroll
                for (int n = 0; n < 2; ++n) { float* d = SCL + (size_t)(pp * 128 + tg * 32 + n * 16 + fr) * LS + m * 16 + fq * 4;
                    d[0] = acc[m][n].x; d[1] = acc[m][n].y; d[2] = acc[m][n].z; d[3] = acc[m][n].w; }
        }
        __syncthreads();
        const int tok = tid & 127, pp = (tid >> 7) & 1, kh = tid >> 8;
        float K1[16];
#pragma unroll
        for (int j = 0; j < 16; ++j) K1[j] = -3.0e38f;
        { const float* sp = SCL + (size_t)(pp * 128 + tok) * LS + kh * 64;
#pragma unroll 8
          for (int k = 0; k < 64; ++k) { const float a = sp[k]; const int id = kh * 64 + k; const float key = __uint_as_float((__float_as_uint(a) & ~127u) | (unsigned)(a >= 0.f ? 127 - id : id)); KEY_INSERT(K1, key); } }
        __syncthreads();
        float* XV = smem;
        if (kh == 1) {
#pragma unroll
            for (int j = 0; j < 16; ++j) XV[(pp * 128 + tok) * 17 + j] = K1[j]; }
        __syncthreads();
        if (kh == 0) {
#pragma unroll 4
            for (int j = 0; j < 16; ++j) { const float key = XV[(pp * 128 + tok) * 17 + j]; KEY_INSERT(K1, key); } }
        __syncthreads();
        if (kh == 0 && pp == 1) {
#pragma unroll
            for (int j = 0; j < 16; ++j) XV[tok * 17 + j] = K1[j]; }
        __syncthreads();
        if (kh == 0 && pp == 0) {
            float K2[16];
#pragma unroll
            for (int j = 0; j < 16; ++j) K2[j] = XV[tok * 17 + j];
            int* XI = (int*)smem + 256 * 17 + tok * 33;
#pragma unroll
            for (int j = 0; j < 16; ++j) { const unsigned b1 = __float_as_uint(K1[j]) & 127u, b2 = __float_as_uint(K2[j]) & 127u; XI[j] = K1[j] >= 0.f ? 127 - (int)b1 : (int)b1; XI[16 + j] = K2[j] >= 0.f ? 127 - (int)b2 : (int)b2; }
            float B[16];
#pragma unroll
            for (int j = 0; j < 16; ++j) B[j] = -3.0e38f;
#pragma unroll
            for (int i = 0; i < 16; ++i)
#pragma unroll
                for (int j = 0; j < 16; ++j) if ((i + 1) * (j + 1) <= 16) { const float sc = K1[i] + K2[j]; const int f = i * 16 + j;
                    const float key = __uint_as_float((__float_as_uint(sc) & ~255u) | (unsigned)(sc >= 0.f ? 255 - f : f)); KEY_INSERT(B, key); }
            float e[16], sum = 0.f; int id[16];
#pragma unroll
            for (int j = 0; j < 16; ++j) { e[j] = __expf(B[j] - B[0]); sum += e[j]; const unsigned bb = __float_as_uint(B[j]) & 255u; const int f = B[j] >= 0.f ? 255 - (int)bb : (int)bb; id[j] = XI[f >> 4] * 128 + XI[16 + (f & 15)]; }
            const float inv = 1.f / sum; const size_t o = ((size_t)(r0 + tok) * 8 + h) * 16;
#pragma unroll
            for (int j = 0; j < 16; j += 4) { *(u32x4*)(EID + o + j) = (u32x4){(unsigned)id[j], (unsigned)id[j + 1], (unsigned)id[j + 2], (unsigned)id[j + 3]};
                *(f32x4*)(GATE + o + j) = (f32x4){e[j] * inv, e[j + 1] * inv, e[j + 2] * inv, e[j + 3] * inv}; }
        }
    }
}
DEVI void ph_subkeys(const Params& p) {
    const f32x4* S = (const f32x4*)p.peer_sub_keys; u32x2* O = (u32x2*)(p.ws + WT_SK);
    for (int i = blockIdx.x * NTHR + tidx(); i < 4 * 16 * 128 * 128 / 4; i += gridDim.x * NTHR) { const f32x4 a = S[i]; u32x2 o; o.x = pk2(a.x, a.y); o.y = pk2(a.z, a.w); O[i] = o; }
}

constexpr int SLD = 144;
DEVI s16x4 trr(int addr) { s16x4 r; asm volatile("ds_read_b64_tr_b16 %0, %1" : "=&v"(r) : "v"(addr) : "memory"); return r; }
#define LGKM0() do { asm volatile("s_waitcnt lgkmcnt(0)" ::: "memory"); SBAR(); } while (0)
DEVI bf16x8 pk8(const s16x4 l, const s16x4 h) { return (bf16x8){l[0], l[1], l[2], l[3], h[0], h[1], h[2], h[3]}; }
DEVI bf16x8 cvt8(const f32x4 a, const f32x4 b) { u32x4 w = {pk2(a.x, a.y), pk2(a.z, a.w), pk2(b.x, b.y), pk2(b.z, b.w)}; return *reinterpret_cast<bf16x8*>(&w); }
#define SCAN_DECODE(it_, n_, dir_, hh_, b_) const int n_ = (it_) % NCHUNK, sc_ = (it_) / NCHUNK, dir_ = sc_ & 1, hh_ = (sc_ >> 1) & 7, b_ = sc_ >> 4
DEVI void ph_scan1(const Params& p, int layer, unsigned char* lds) {
    const int jl = layer >> 1, tid = tidx(), wid = tid >> 6, lane = tid & 63, fr = lane & 15, fq = lane >> 4, k2 = lane * 2, Ig = wid;
    const float* LF = (const float*)(p.ws + WS_LF); const bf16 *VS = (const bf16*)(p.ws + WS_VS), *KR = (const bf16*)(p.ws + WS_KR);
    unsigned char* UT = p.ws + WS_UT; float* DEC = (float*)(p.ws + WS_DEC);
    bf16* KH = (bf16*)lds; bf16* VV = KH + 64 * SLD; float* TOT = (float*)(VV + 64 * SLD);
    const int trb = (int)(uintptr_t)lds + (((lane >> 2) & 3) * SLD + (lane & 3) * 4) * 2;
    const int NIT = 32 * NCHUNK, G = gridDim.x;
    f32x2 rlf[8]; unsigned rkr[8], rvs[8];
#define S1_LOAD(itx) do { SCAN_DECODE(itx, n2, dir2, hh2, b2); \
        if (hh2 < 4) { _Pragma("unroll") for (int i = 0; i < 8; ++i) rlf[i] = *(const f32x2*)(LF + ((size_t)dir2 * T + scan_row(b2, dir2, n2 * 64 + Ig * 8 + i)) * 512 + hh2 * 128 + k2); } \
        else { _Pragma("unroll") for (int i = 0; i < 8; ++i) rkr[i] = *(const unsigned*)(KR + (size_t)scan_row(b2, dir2, n2 * 64 + Ig * 8 + i) * 512 + (hh2 - 4) * 128 + k2); } \
        _Pragma("unroll") for (int i = 0; i < 8; ++i) rvs[i] = *(const unsigned*)(VS + (size_t)scan_row(b2, dir2, n2 * 64 + Ig * 8 + i) * 1024 + hh2 * 128 + k2); } while (0)
    if ((int)blockIdx.x < NIT) S1_LOAD((int)blockIdx.x);
    for (int it = blockIdx.x; it < NIT; it += G) {
        SCAN_DECODE(it, n, dir, hh, b); (void)n; (void)b;
        const float lg = hh >= 4 ? -__expf(p.ret_log_decay[(jl * 2 + dir) * 4 + (hh - 4)]) : 0.f;
        f32x2 lc[8], kk[8]; f32x2 run = {0.f, 0.f};
#pragma unroll
        for (int i = 0; i < 8; ++i) { const f32x2 lf = hh < 4 ? rlf[i] : (f32x2){lg, lg}; const f32x2 kv = hh < 4 ? (f32x2){1.f - __expf(lf.x), 1.f - __expf(lf.y)} : (f32x2){bflo(rkr[i]), bfhi(rkr[i])}; run += lf; lc[i] = run; kk[i] = kv; }
        *(f32x2*)(TOT + Ig * 128 + k2) = run;
        __syncthreads();
        f32x2 after = {0.f, 0.f};
#pragma unroll
        for (int J = 0; J < 8; ++J) if (J > Ig) after += *(const f32x2*)(TOT + J * 128 + k2);
        const f32x2 ea = {__expf(after.x + run.x), __expf(after.y + run.y)};
        if (Ig == 0) *(f32x2*)(DEC + (size_t)it * 128 + k2) = ea;
#pragma unroll
        for (int i = 0; i < 8; ++i) { *(unsigned*)(KH + (Ig * 8 + i) * SLD + k2) = pk2(kk[i].x * __expf(-lc[i].x) * ea.x, kk[i].y * __expf(-lc[i].y) * ea.y); *(unsigned*)(VV + (Ig * 8 + i) * SLD + k2) = rvs[i]; }
        if (it + G < NIT) S1_LOAD(it + G);
        __syncthreads();
        f32x4 acc[8];
#pragma unroll
        for (int a = 0; a < 8; ++a) acc[a] = (f32x4){0.f, 0.f, 0.f, 0.f};
#pragma unroll
        for (int t = 0; t < 2; ++t) {
            const int rb = trb + ((32 * t + 8 * fq) * SLD) * 2;
            const s16x4 al = trr(rb + (16 * wid) * 2), ah = trr(rb + (4 * SLD + 16 * wid) * 2);
            s16x4 bl[8], bh[8];
#pragma unroll
            for (int nt = 0; nt < 8; ++nt) { bl[nt] = trr(rb + (64 * SLD + 16 * nt) * 2); bh[nt] = trr(rb + (68 * SLD + 16 * nt) * 2); }
            LGKM0();
            const bf16x8 A = pk8(al, ah);
#pragma unroll
            for (int nt = 0; nt < 8; ++nt) acc[nt] = __builtin_amdgcn_mfma_f32_16x16x32_bf16(A, pk8(bl[nt], bh[nt]), acc[nt], 0, 0, 0);
        }
        unsigned char* U = UT + (size_t)it * 16384 + 16 * wid + fq * 4;
#pragma unroll
        for (int nt = 0; nt < 8; ++nt) *(unsigned*)(U + (size_t)(nt * 16 + fr) * 128) = pk4f8(acc[nt].x, acc[nt].y, acc[nt].z, acc[nt].w);
    }
#undef S1_LOAD
}
DEVI void ph_scan2(const Params& p) {
    u32x2* UT = (u32x2*)(p.ws + WS_UT); const float* DEC = (const float*)(p.ws + WS_DEC); const int tid = tidx();
    for (int it = blockIdx.x; it < 32 * 4; it += gridDim.x) {
        const int sc = it >> 2, e8 = (it & 3) * NTHR + tid, k8 = (e8 & 15) * 8; float st[8];
#pragma unroll
        for (int i = 0; i < 8; ++i) st[i] = 0.f;
        u32x2* u = UT + (size_t)sc * NCHUNK * 2048 + e8; const float* dp = DEC + (size_t)sc * NCHUNK * 128 + k8;
        for (int n0 = 0; n0 < NCHUNK; n0 += 4) {
            u32x2 uu[4]; f32x4 d0[4], d1[4];
#pragma unroll
            for (int j = 0; j < 4; ++j) { uu[j] = u[(size_t)(n0 + j) * 2048]; d0[j] = *(const f32x4*)(dp + (size_t)(n0 + j) * 128); d1[j] = *(const f32x4*)(dp + (size_t)(n0 + j) * 128 + 4); }
#pragma unroll
            for (int j = 0; j < 4; ++j) {
                u32x2 o; o.x = pk4f8(st[0], st[1], st[2], st[3]); o.y = pk4f8(st[4], st[5], st[6], st[7]); u[(size_t)(n0 + j) * 2048] = o;
                const f32x4 a = up4f8(uu[j].x), b2 = up4f8(uu[j].y);
                st[0] = d0[j].x * st[0] + a.x; st[1] = d0[j].y * st[1] + a.y; st[2] = d0[j].z * st[2] + a.z; st[3] = d0[j].w * st[3] + a.w;
                st[4] = d1[j].x * st[4] + b2.x; st[5] = d1[j].y * st[5] + b2.y; st[6] = d1[j].z * st[6] + b2.z; st[7] = d1[j].w * st[7] + b2.w;
            }
        }
    }
}
DEVI void ph_scan3(const Params& p, int layer, unsigned char* lds) {
    const int jl = layer >> 1, tid = tidx(), wid = tid >> 6, lane = tid & 63, fr = lane & 15, fq = lane >> 4, k2 = lane * 2, Ig = wid, I = wid >> 1, hb = wid & 1;
    const float* LF = (const float*)(p.ws + WS_LF); const bf16 *VS = (const bf16*)(p.ws + WS_VS), *KR = (const bf16*)(p.ws + WS_KR), *QS = (const bf16*)(p.ws + WS_QS);
    const unsigned char* UT = p.ws + WS_UT; bf16* OFB = (bf16*)(p.ws + WS_OFB);
    bf16* QH = (bf16*)lds; bf16* QT = QH + 64 * SLD; bf16* VV = QT + 64 * SLD; bf16* KT = VV + 64 * SLD; float* TOT = (float*)(KT + 160 * SLD);
    const int trv = (int)(uintptr_t)VV + (((lane >> 2) & 3) * SLD + (lane & 3) * 4 + 16 * wid) * 2 + (4 * fq * SLD) * 2;
    const int NIT = 32 * NCHUNK, G = gridDim.x;
    f32x2 rlf[8]; unsigned rkr[8], rvs[8], rqs[8];
#define S3_LOAD(itx) do { SCAN_DECODE(itx, n2, dir2, hh2, b2); \
        if (hh2 < 4) { _Pragma("unroll") for (int i = 0; i < 8; ++i) rlf[i] = *(const f32x2*)(LF + ((size_t)dir2 * T + scan_row(b2, dir2, n2 * 64 + Ig * 8 + i)) * 512 + hh2 * 128 + k2); } \
        else { _Pragma("unroll") for (int i = 0; i < 8; ++i) rkr[i] = *(const unsigned*)(KR + (size_t)scan_row(b2, dir2, n2 * 64 + Ig * 8 + i) * 512 + (hh2 - 4) * 128 + k2); } \
        _Pragma("unroll") for (int i = 0; i < 8; ++i) { const int row = scan_row(b2, dir2, n2 * 64 + Ig * 8 + i); rvs[i] = *(const unsigned*)(VS + (size_t)row * 1024 + hh2 * 128 + k2); rqs[i] = *(const unsigned*)(QS + (size_t)row * 1024 + hh2 * 128 + k2); } } while (0)
    if ((int)blockIdx.x < NIT) S3_LOAD((int)blockIdx.x);
    for (int it = blockIdx.x; it < NIT; it += G) {
        SCAN_DECODE(it, n, dir, hh, b);
        const float lg = hh >= 4 ? -__expf(p.ret_log_decay[(jl * 2 + dir) * 4 + (hh - 4)]) : 0.f;
        bf16x8 stv[4];
        { const unsigned char* ST = UT + (size_t)it * 16384 + (size_t)(16 * wid + fr) * 128 + fq * 8;
#pragma unroll
          for (int ks = 0; ks < 4; ++ks) { const u32x2 w = *(const u32x2*)(ST + ks * 32); const f32x4 a = up4f8(w.x), b2 = up4f8(w.y);
              const u32x4 q = {pk2(a.x, a.y), pk2(a.z, a.w), pk2(b2.x, b2.y), pk2(b2.z, b2.w)}; stv[ks] = __builtin_bit_cast(bf16x8, q); } }
        f32x2 lc[8], kk[8]; f32x2 run = {0.f, 0.f};
#pragma unroll
        for (int i = 0; i < 8; ++i) { const f32x2 lf = hh < 4 ? rlf[i] : (f32x2){lg, lg}; const f32x2 kv = hh < 4 ? (f32x2){1.f - __expf(lf.x), 1.f - __expf(lf.y)} : (f32x2){bflo(rkr[i]), bfhi(rkr[i])}; run += lf; lc[i] = run; kk[i] = kv; }
        *(f32x2*)(TOT + Ig * 128 + k2) = run;
        __syncthreads();
        f32x2 tg[8];
#pragma unroll
        for (int J = 0; J < 8; ++J) tg[J] = *(const f32x2*)(TOT + J * 128 + k2);
        f32x2 ref = {0.f, 0.f}, base = {0.f, 0.f};
#pragma unroll
        for (int J = 0; J < 8; ++J) { if (J < 2 * I) ref += tg[J]; if (hb && J == 2 * I) base = tg[J]; }
        { const f32x2 er = {__expf(ref.x), __expf(ref.y)};
#pragma unroll
          for (int i = 0; i < 8; ++i) { const int c = Ig * 8 + i; const f32x2 e = {__expf(lc[i].x + base.x), __expf(lc[i].y + base.y)};
              const f32x2 qt = (f32x2){bflo(rqs[i]), bfhi(rqs[i])} * e;
              *(unsigned*)(QH + c * SLD + k2) = pk2(qt.x * er.x, qt.y * er.y); *(unsigned*)(QT + c * SLD + k2) = pk2(qt.x, qt.y); *(unsigned*)(VV + c * SLD + k2) = rvs[i];
              kk[i].x *= __builtin_amdgcn_rcpf(e.x); kk[i].y *= __builtin_amdgcn_rcpf(e.y); } }
        { f32x2 delta = {0.f, 0.f};
#pragma unroll
          for (int I2 = 0; I2 < 4; ++I2) { if (I2 >= I) { bf16* kt = KT + ((I2 * (I2 + 1) / 2 + I) * 16 + hb * 8) * SLD + k2; const f32x2 ed = {__expf(delta.x), __expf(delta.y)};
#pragma unroll
                  for (int i = 0; i < 8; ++i) *(unsigned*)(kt + i * SLD) = pk2(kk[i].x * ed.x, kk[i].y * ed.y);
                  delta += tg[2 * I2] + tg[2 * I2 + 1]; } } }
        if (it + G < NIT) S3_LOAD(it + G);
        __syncthreads();
        f32x4 acc[4];
#pragma unroll
        for (int a = 0; a < 4; ++a) acc[a] = (f32x4){0.f, 0.f, 0.f, 0.f};
#pragma unroll
        for (int ks = 0; ks < 4; ++ks) { const bf16x8 A = stv[ks];
#pragma unroll
            for (int c4 = 0; c4 < 4; ++c4) acc[c4] = __builtin_amdgcn_mfma_f32_16x16x32_bf16(A, *(const bf16x8*)(QH + (c4 * 16 + fr) * SLD + ks * 32 + fq * 8), acc[c4], 0, 0, 0); }
#pragma unroll
        for (int I2 = 0; I2 < 4; ++I2) {
            f32x4 at[4];
#pragma unroll
            for (int J = 0; J < 4; ++J) { at[J] = (f32x4){0.f, 0.f, 0.f, 0.f};
                if (J <= I2) {
#pragma unroll
                    for (int ks = 0; ks < 4; ++ks) at[J] = __builtin_amdgcn_mfma_f32_16x16x32_bf16(*(const bf16x8*)(KT + ((I2 * (I2 + 1) / 2 + J) * 16 + fr) * SLD + ks * 32 + fq * 8),
                                                                                                   *(const bf16x8*)(QT + (I2 * 16 + fr) * SLD + ks * 32 + fq * 8), at[J], 0, 0, 0);
                    if (J == I2) { if (fq * 4 + 0 > fr) at[J].x = 0.f; if (fq * 4 + 1 > fr) at[J].y = 0.f; if (fq * 4 + 2 > fr) at[J].z = 0.f; if (fq * 4 + 3 > fr) at[J].w = 0.f; }
                } }
#pragma unroll
            for (int t = 0; t < 2; ++t) if (2 * t <= I2) {
                const s16x4 vl = trr(trv + ((2 * t) * 16 * SLD) * 2), vh = trr(trv + ((2 * t + 1) * 16 * SLD) * 2);
                LGKM0();
                acc[I2] = __builtin_amdgcn_mfma_f32_16x16x32_bf16(pk8(vl, vh), cvt8(at[2 * t], at[2 * t + 1]), acc[I2], 0, 0, 0);
            }
        }
#pragma unroll
        for (int c4 = 0; c4 < 4; ++c4) { const int row = scan_row(b, dir, n * 64 + c4 * 16 + fr);
            *(u32x2*)(OFB + ((size_t)dir * T + row) * 1024 + hh * 128 + 16 * wid + fq * 4) = pk4(acc[c4]); }
    }
#undef S3_LOAD
}

constexpr size_t WT_GW = WS_WT + 54 * MiB;
DEVI void ph_gmlp(const Params& p, int layer, unsigned char* lds) {
    const int j = layer >> 1, tid = tidx(), wid = tid >> 6, lane = tid & 63, fr = lane & 15, fq = lane >> 4;
    const bf16 *UB = (const bf16*)(p.ws + WS_UB), *VG = (const bf16*)(p.ws + WS_VG); bf16* OX = (bf16*)(p.ws + WS_OX);
    bf16* VN = (bf16*)lds;
    const int trb = (int)(uintptr_t)lds + (((lane >> 2) & 3) * SLD + (lane & 3) * 4 + 16 * wid) * 2 + (8 * fq * SLD) * 2;
    const int nfull = ((T / 128) * 4 / (int)gridDim.x) * (int)gridDim.x;
    for (int k = 0;; ++k) {
        int it = k * (int)gridDim.x + (int)blockIdx.x;
        if (it >= nfull) { const int rem = (int)blockIdx.x - 16; if (k * (int)gridDim.x != nfull || rem < 0 || nfull + rem >= (T / 128) * 4) break; it = nfull + rem; }
        const int ch = it >> 2, g = it & 3, r0 = ch * 128;
        __syncthreads();
        u32x4 arow[16];
#pragma unroll
        for (int rr = 0; rr < 16; ++rr) arow[rr] = *(const u32x4*)(VG + (size_t)(r0 + wid * 16 + rr) * 512 + lane * 8);
#pragma unroll
        for (int rr = 0; rr < 16; ++rr) {
            const int row = wid * 16 + rr; const u32x4 a = arow[rr];
            float x[8] = {bflo(a.x), bfhi(a.x), bflo(a.y), bfhi(a.y), bflo(a.z), bfhi(a.z), bflo(a.w), bfhi(a.w)};
            float sm = 0.f;
#pragma unroll
            for (int i = 0; i < 8; ++i) sm += x[i];
            const float mean = wave_sum(sm) * (1.f / 512.f); float qq = 0.f;
#pragma unroll
            for (int i = 0; i < 8; ++i) { x[i] -= mean; qq += x[i] * x[i]; }
            const float rstd = rsqrtf(wave_sum(qq) * (1.f / 512.f) + EPS);
            if ((lane >> 4) == g) { const float* gn = p.gmlp_v_gain + j * 512 + lane * 8; const f32x4 g0 = *(const f32x4*)gn, g1 = *(const f32x4*)(gn + 4);
                u32x4 o; o.x = pk2(x[0] * rstd * g0.x, x[1] * rstd * g0.y); o.y = pk2(x[2] * rstd * g0.z, x[3] * rstd * g0.w); o.z = pk2(x[4] * rstd * g1.x, x[5] * rstd * g1.y); o.w = pk2(x[6] * rstd * g1.z, x[7] * rstd * g1.w);
                *(u32x4*)(VN + row * SLD + (lane & 15) * 8) = o; }
        }
        __syncthreads();
        const bf16* WB = (const bf16*)(p.ws + WT_GW) + (size_t)(j * 4 + g) * 128 * 128;
        f32x4 acc[8];
#pragma unroll
        for (int a = 0; a < 8; ++a) acc[a] = (f32x4){0.f, 0.f, 0.f, 0.f};
#pragma unroll
        for (int ks = 0; ks < 4; ++ks) {
            bf16x8 bw[8];
#pragma unroll
            for (int nt = 0; nt < 8; ++nt) bw[nt] = *(const bf16x8*)(WB + (size_t)(nt * 16 + fr) * 128 + ks * 32 + fq * 8);
            const s16x4 al = trr(trb + (32 * ks * SLD) * 2), ah = trr(trb + ((32 * ks + 4) * SLD) * 2);
            LGKM0();
            const bf16x8 A = pk8(al, ah);
#pragma unroll
            for (int nt = 0; nt < 8; ++nt) acc[nt] = __builtin_amdgcn_mfma_f32_16x16x32_bf16(A, bw[nt], acc[nt], 0, 0, 0);
        }
#pragma unroll
        for (int nt = 0; nt < 8; ++nt) { const int pi = nt * 16 + fr; const float bsv = p.gmlp_bs[(j * 4 + g) * 128 + pi];
            const size_t o = (size_t)(r0 + pi) * 1024 + g * 128 + 16 * wid + fq * 4; const u32x2 uu = *(const u32x2*)(UB + (size_t)(r0 + pi) * 512 + g * 128 + 16 * wid + fq * 4);
            u32x2 w; w.x = pk2(bflo(uu.x) * (acc[nt].x + bsv), bfhi(uu.x) * (acc[nt].y + bsv)); w.y = pk2(bflo(uu.y) * (acc[nt].z + bsv), bfhi(uu.y) * (acc[nt].w + bsv));
            *(u32x2*)(OX + o) = w; }
    }
}
DEVI void ph_gmlp_weights(const Params& p) {
    const f32x4* S = (const f32x4*)p.gmlp_ws; u32x2* O = (u32x2*)(p.ws + WT_GW);
    for (int i = blockIdx.x * NTHR + tidx(); i < 2 * 4 * 128 * 128 / 4; i += gridDim.x * NTHR) { const f32x4 a = S[i]; u32x2 o; o.x = pk2(a.x, a.y); o.y = pk2(a.z, a.w); O[i] = o; }
}

namespace pg8 {
#define PG8_LAS __attribute__((address_space(3)))
typedef unsigned short bf16_t;
typedef short bf16x8 __attribute__((ext_vector_type(8)));
typedef float f32x4 __attribute__((ext_vector_type(4)));
typedef unsigned u32x4 __attribute__((ext_vector_type(4)));
constexpr int BM = 256, BK = 64, HALF = 128, HTB = HALF * BK * 2  , STAGE_BYTES = 8 * HTB, NXCD = 8, WGM = 8;

__host__ __device__ __forceinline__ int lds_byte(int r, int c) { const int st = (r >> 4) * 2 + (c >> 5), rr = r & 15, cc = c & 31, ob = rr * 64 + cc * 2; return st * 1024 + (ob ^ (((ob >> 9) & 1) << 5)); }
__host__ __device__ __forceinline__ void stage_rc(int b, int& R, int& C) { const int st = b / 1024, sb = b % 1024, swz = sb ^ (((sb >> 9) & 1) << 5); R = (st >> 1) * 16 + swz / 64; C = (st & 1) * 32 + (swz % 64) / 2; }
__host__ __device__ __forceinline__ int perm32(int rho) { const int n = rho >> 4, i = rho & 15; return 8 * (i >> 2) + 4 * n + (i & 3); }

struct Unit { int pm, pn; };
struct Gemm { const bf16_t* A; const bf16_t* Bt; int M, N, K; };

struct StaticOrder {
    int nM, nN, nwg, G, c;
    __host__ __device__ void init(int M, int N, int G_, int c_) { nM = M / BM; nN = N / BM; nwg = nM * nN; G = G_; c = c_; }
    __host__ __device__ bool next(int i, Unit& u) const {
        const long L = (long)i * G + c; if (L >= nwg) return false;
        int wgid = (int)L; { const int q = nwg / NXCD, r = nwg % NXCD, xcd = wgid % NXCD, off = wgid / NXCD; wgid = (xcd < r ? xcd * (q + 1) : r * (q + 1) + (xcd - r) * q) + off; }
        const int nig = WGM * nN, gid = wgid / nig, fm = gid * WGM, gsz = (nM - fm) < WGM ? (nM - fm) : WGM;
        u.pm = fm + ((wgid % nig) % gsz); u.pn = (wgid % nig) / gsz; return true;
    }
    __device__ __forceinline__ void a_ready(const Unit&) const {}
    __device__ __forceinline__ void done(const Unit&) const {}
};

template <class Epi, class Sched, bool ALIGN_EPI = false, bool SP2 = false>
__device__ __forceinline__ void gemm_phase(PG8_LAS unsigned char* lds, const Gemm g, const Sched& S, const Epi& E) {
    const int tid = tidx(), wid = __builtin_amdgcn_readfirstlane(tid >> 6), lane = tid & 63, wr = wid >> 2, wc = wid & 3, fr = lane & 15, fq = lane >> 4;
    const int K = g.K, nt = K / BK;
    unsigned voffA[2], voffB[2];
#pragma unroll
    for (int i = 0; i < 2; ++i) { int R, C; stage_rc(tid * 16 + i * 8192, R, C); const int Rb = Epi::PERM ? ((R & ~31) + perm32(R & 31)) : R;
        voffA[i] = (unsigned)(R * K + C) * 2u; voffB[i] = (unsigned)(Rb * K + C) * 2u; }
    const size_t kstep = (size_t)(BK * 2);
    const size_t hstep = (size_t)HALF * K * 2;
    const size_t tstep = 2 * hstep;
    const unsigned ldsw = (unsigned)wid * 1024u;
    const int aoff = lds_byte(wr * 64 + fr, fq * 8), boff = lds_byte(wc * 32 + fr, fq * 8);
#define PG8_SA(b, h) (((b) * 2 + (h)) * HTB)
#define PG8_SB(b, h) ((4 + (b) * 2 + (h)) * HTB)
#define PG8_STAGE(bufoff, gbase, voff) do { _Pragma("unroll") for (int _i = 0; _i < 2; ++_i) \
        __builtin_amdgcn_global_load_lds((const unsigned*)((const char*)(gbase) + (voff)[_i]), (PG8_LAS unsigned*)(lds + (bufoff) + ldsw + _i * 8192), 16, 0, 0); } while (0)
#define PG8_LDA(dst, b, h) do { _Pragma("unroll") for (int m = 0; m < 4; ++m) _Pragma("unroll") for (int k = 0; k < 2; ++k) dst[m][k] = *(const PG8_LAS bf16x8*)(lds + PG8_SA(b, h) + aoff + m * 2048 + k * 1024); } while (0)
#define PG8_LDB(dst, b, h) do { _Pragma("unroll") for (int n = 0; n < 2; ++n) _Pragma("unroll") for (int k = 0; k < 2; ++k) dst[n][k] = *(const PG8_LAS bf16x8*)(lds + PG8_SB(b, h) + boff + n * 2048 + k * 1024); } while (0)
#define PG8_MMA(ai, bj, At, Bt) do { __builtin_amdgcn_s_setprio(1); _Pragma("unroll") for (int m = 0; m < 4; ++m) _Pragma("unroll") for (int n = 0; n < 2; ++n) _Pragma("unroll") for (int k = 0; k < 2; ++k) \
        acc[ai][bj][m][n] = __builtin_amdgcn_mfma_f32_16x16x32_bf16(Bt[n][k], At[m][k], acc[ai][bj][m][n], 0, 0, 0); __builtin_amdgcn_s_setprio(0); } while (0)
#define PG8_WAIT_V(n) asm volatile("s_waitcnt vmcnt(" #n ")" ::: "memory")
#define PG8_WAIT_L(n) asm volatile("s_waitcnt lgkmcnt(" #n ")" ::: "memory")
#define PG8_BAR __builtin_amdgcn_s_barrier()
#define PG8_SCHED __builtin_amdgcn_sched_barrier(0)
    Unit cur, nxt; int ui = 0;
    if (!S.next(0, cur)) return;
    f32x4 acc[2][2][4][2];
#pragma unroll
    for (int a = 0; a < 2; ++a)
#pragma unroll
        for (int b = 0; b < 2; ++b)
#pragma unroll
            for (int m = 0; m < 4; ++m)
#pragma unroll
                for (int n = 0; n < 2; ++n) acc[a][b][m][n] = (f32x4){0.f, 0.f, 0.f, 0.f};
    bf16x8 At[4][2], B0[2][2], B1[2][2];
    const char* cA = (const char*)g.A + (size_t)cur.pm * tstep; const char* cB = (const char*)g.Bt + (size_t)cur.pn * tstep;
    S.a_ready(cur);
    if constexpr (SP2) {
        PG8_STAGE(PG8_SB(0, 0), cB, voffB); PG8_STAGE(PG8_SB(0, 1), cB + hstep, voffB); PG8_STAGE(PG8_SA(0, 0), cA, voffA); PG8_STAGE(PG8_SA(0, 1), cA + hstep, voffA);
        if (wr == 1) PG8_BAR;
        PG8_WAIT_V(2); PG8_BAR;
        PG8_STAGE(PG8_SB(1, 0), cB + kstep, voffB); PG8_STAGE(PG8_SA(1, 0), cA + kstep, voffA); PG8_STAGE(PG8_SB(1, 1), cB + hstep + kstep, voffB);
        PG8_WAIT_V(6); PG8_BAR;
    } else {
        PG8_STAGE(PG8_SB(0, 0), cB, voffB); PG8_STAGE(PG8_SA(0, 0), cA, voffA); PG8_STAGE(PG8_SB(0, 1), cB + hstep, voffB); PG8_STAGE(PG8_SA(0, 1), cA + hstep, voffA);
        if (wr == 1) PG8_BAR;
        PG8_WAIT_V(4); PG8_BAR;
        PG8_STAGE(PG8_SB(1, 0), cB + kstep, voffB); PG8_STAGE(PG8_SA(1, 0), cA + kstep, voffA); PG8_STAGE(PG8_SB(1, 1), cB + hstep + kstep, voffB);
        PG8_WAIT_V(6); PG8_BAR;
    }
    for (;;) {
        const bool has_next = S.next(ui + 1, nxt);
        const char* nA = has_next ? (const char*)g.A + (size_t)nxt.pm * tstep : cA; const char* nB = has_next ? (const char*)g.Bt + (size_t)nxt.pn * tstep : cB;
        for (int t = 0; t < nt; t += 2) {
            const bool last = (t == nt - 2);
            const char* a1 = cA + (size_t)(t + 1) * kstep;
            const char* a2 = last ? nA : cA + (size_t)(t + 2) * kstep; const char* b2 = last ? nB : cB + (size_t)(t + 2) * kstep;
            const char* a3 = a2 + kstep; const char* b3 = b2 + kstep;
            if (last && has_next) S.a_ready(nxt);
            if constexpr (SP2) {
            PG8_LDB(B0, 0, 0); PG8_LDB(B1, 0, 1); PG8_SCHED; PG8_LDA(At, 0, 0); PG8_STAGE(PG8_SA(1, 1), a1 + hstep, voffA);
            PG8_WAIT_V(8); PG8_WAIT_L(0); PG8_BAR; PG8_MMA(0, 0, At, B0); PG8_MMA(0, 1, At, B1); PG8_BAR; PG8_SCHED;
            PG8_LDA(At, 0, 1); PG8_STAGE(PG8_SB(0, 0), b2, voffB); PG8_STAGE(PG8_SB(0, 1), b2 + hstep, voffB); PG8_STAGE(PG8_SA(0, 0), a2, voffA);
            PG8_WAIT_V(8); PG8_WAIT_L(0); PG8_BAR; PG8_MMA(1, 0, At, B0); PG8_MMA(1, 1, At, B1); PG8_BAR; PG8_SCHED;
            PG8_LDB(B0, 1, 0); PG8_LDB(B1, 1, 1); PG8_SCHED; PG8_LDA(At, 1, 0); PG8_STAGE(PG8_SA(0, 1), a2 + hstep, voffA);
            PG8_WAIT_V(8); PG8_WAIT_L(0); PG8_BAR; PG8_MMA(0, 0, At, B0); PG8_MMA(0, 1, At, B1); PG8_BAR; PG8_SCHED;
            PG8_LDA(At, 1, 1); PG8_STAGE(PG8_SB(1, 0), b3, voffB); PG8_STAGE(PG8_SB(1, 1), b3 + hstep, voffB); PG8_STAGE(PG8_SA(1, 0), a3, voffA);
            PG8_WAIT_V(8); PG8_WAIT_L(0); PG8_BAR; PG8_MMA(1, 0, At, B0); PG8_MMA(1, 1, At, B1); PG8_BAR; PG8_SCHED;
            } else {
            PG8_LDB(B0, 0, 0); PG8_SCHED; PG8_LDA(At, 0, 0); PG8_STAGE(PG8_SA(1, 1), a1 + hstep, voffA);
            PG8_WAIT_L(8); PG8_BAR; PG8_WAIT_L(0); PG8_MMA(0, 0, At, B0); PG8_BAR; PG8_SCHED;
            PG8_LDB(B1, 0, 1); PG8_STAGE(PG8_SB(0, 0), b2, voffB);
            PG8_BAR; PG8_WAIT_L(0); PG8_MMA(0, 1, At, B1); PG8_BAR;
            PG8_LDA(At, 0, 1); PG8_STAGE(PG8_SA(0, 0), a2, voffA);
            PG8_BAR; PG8_WAIT_L(0); PG8_MMA(1, 0, At, B0); PG8_BAR; PG8_SCHED;
            PG8_STAGE(PG8_SB(0, 1), b2 + hstep, voffB);
            PG8_WAIT_V(6); PG8_BAR; PG8_MMA(1, 1, At, B1); PG8_BAR;
            PG8_LDB(B0, 1, 0); PG8_SCHED; PG8_LDA(At, 1, 0); PG8_STAGE(PG8_SA(0, 1), a2 + hstep, voffA);
            PG8_WAIT_L(8); PG8_BAR; PG8_WAIT_L(0); PG8_MMA(0, 0, At, B0); PG8_BAR; PG8_SCHED;
            PG8_LDB(B1, 1, 1); PG8_STAGE(PG8_SB(1, 0), b3, voffB);
            PG8_BAR; PG8_WAIT_L(0); PG8_MMA(0, 1, At, B1); PG8_BAR;
            PG8_LDA(At, 1, 1); PG8_STAGE(PG8_SA(1, 0), a3, voffA);
            PG8_BAR; PG8_WAIT_L(0); PG8_MMA(1, 0, At, B0); PG8_BAR; PG8_SCHED;
            PG8_STAGE(PG8_SB(1, 1), b3 + hstep, voffB);
            PG8_WAIT_V(6); PG8_BAR; PG8_MMA(1, 1, At, B1); PG8_BAR;
            }
        }
        if constexpr (ALIGN_EPI) { if (wr == 0) PG8_BAR; }
        if constexpr (!Epi::AFTER_DRAIN) { E(acc, cur, wr, wc, fr, fq); S.done(cur); }
        if (!has_next) break;
#pragma unroll
        for (int a = 0; a < 2; ++a)
#pragma unroll
            for (int b = 0; b < 2; ++b)
#pragma unroll
                for (int m = 0; m < 4; ++m)
#pragma unroll
                    for (int n = 0; n < 2; ++n) acc[a][b][m][n] = (f32x4){0.f, 0.f, 0.f, 0.f};
        cur = nxt; cA = nA; cB = nB; ++ui;
        if constexpr (ALIGN_EPI) { if (wr == 1) PG8_BAR; }
    }
    PG8_WAIT_V(0);
    if constexpr (!ALIGN_EPI) { if (wr == 0) PG8_BAR; }
    PG8_BAR;
    if constexpr (Epi::AFTER_DRAIN) { E.fused(acc, cur, wr, wc, fr, fq, lds, wid, lane); S.done(cur); }
#undef PG8_SA
#undef PG8_SB
#undef PG8_STAGE
#undef PG8_LDA
#undef PG8_LDB
#undef PG8_MMA
#undef PG8_WAIT_V
#undef PG8_WAIT_L
#undef PG8_BAR
#undef PG8_SCHED
}
}

namespace pg8 {
DEVI void rope_pair(f32x4& x1, f32x4& x2, float pos, const float (&inv)[4]) {
    const float a0 = pos * inv[0], a1 = pos * inv[1], a2 = pos * inv[2], a3 = pos * inv[3];
    const float c0 = __cosf(a0), s0 = __sinf(a0), c1 = __cosf(a1), s1 = __sinf(a1), c2 = __cosf(a2), s2 = __sinf(a2), c3 = __cosf(a3), s3 = __sinf(a3);
    const f32x4 y1 = {x1.x * c0 - x2.x * s0, x1.y * c1 - x2.y * s1, x1.z * c2 - x2.z * s2, x1.w * c3 - x2.w * s3};
    const f32x4 y2 = {x1.x * s0 + x2.x * c0, x1.y * s1 + x2.y * c1, x1.z * s2 + x2.z * c2, x1.w * s3 + x2.w * c3};
    x1 = y1; x2 = y2;
}
DEVI f32x4 gelu4(f32x4 v) { return (f32x4){gelu_(v.x), gelu_(v.y), gelu_(v.z), gelu_(v.w)}; }
DEVI f32x4 silu4(f32x4 v) { return (f32x4){silu_(v.x), silu_(v.y), silu_(v.z), silu_(v.w)}; }
struct EpiEvenP {
    static constexpr bool PERM = false, AFTER_DRAIN = false; unsigned char* ws;
    DEVI void operator()(const f32x4 (&acc)[2][2][4][2], const Unit& u, int wr, int wc, int fr, int fq) const {
        const int blk = u.pn >> 1;
        ::bf16* dst = (::bf16*)(ws + (blk == 0 ? WS_KB : blk == 1 ? WS_VB : blk == 2 ? WS_UB : blk == 3 ? WS_VG : WS_QB));
        float inv[4];
#pragma unroll
        for (int j = 0; j < 4; ++j) inv[j] = exp2f(-(float)(4 * fq + j) * (13.287712379549449f / 16.f));
#pragma unroll
        for (int bj = 0; bj < 2; ++bj) { const int cc0 = ((u.pn & 1) * 256 + 128 * bj + 32 * wc) + 4 * fq;
#pragma unroll
            for (int ai = 0; ai < 2; ++ai)
#pragma unroll
                for (int m = 0; m < 4; ++m) { const int r = u.pm * BM + 128 * ai + 64 * wr + 16 * m + fr; f32x4 x1 = acc[ai][bj][m][0], x2 = acc[ai][bj][m][1];
                    if (blk == 0 || blk == 4) { const int t = r & (SEQ - 1); rope_pair(x1, x2, (float)((wc & 1) ? (t & 63) : (t >> 6)), inv);
                        if (blk == 4) { x1 = x1 * (DIFF_SCALE * LOG2E); x2 = x2 * (DIFF_SCALE * LOG2E); } }
                    else if (blk >= 2) { x1 = gelu4(x1); x2 = gelu4(x2); }
                    *(u32x2*)(dst + (size_t)r * 512 + cc0) = pk4(x1); *(u32x2*)(dst + (size_t)r * 512 + cc0 + 16) = pk4(x2); } }
    }
};
struct EpiOddP {
    static constexpr bool PERM = false, AFTER_DRAIN = false; unsigned char* ws; const float* LB;
    DEVI void operator()(const f32x4 (&acc)[2][2][4][2], const Unit& u, int wr, int wc, int fr, int fq) const {
        const int blk = u.pn >> 1;
        float inv[4];
#pragma unroll
        for (int j = 0; j < 4; ++j) inv[j] = exp2f(-(float)((wc & 1) * 16 + 4 * fq + j) * (13.287712379549449f / 32.f));
#pragma unroll
        for (int bj = 0; bj < 2; ++bj) { const int cb = (u.pn & 1) * 256 + 128 * bj;
            const int cc0 = cb + 32 * wc + 4 * fq;
            const int lc0 = cb + (wc >> 1) * 64 + (wc & 1) * 16 + 4 * fq;
#pragma unroll
            for (int ai = 0; ai < 2; ++ai)
#pragma unroll
                for (int m = 0; m < 4; ++m) { const int r = u.pm * BM + 128 * ai + 64 * wr + 16 * m + fr; f32x4 x1 = acc[ai][bj][m][0], x2 = acc[ai][bj][m][1];
                    if (blk <= 1) { float* LF = (float*)(ws + WS_LF) + ((size_t)blk * T + r) * 512 + cc0; const f32x4 l1 = *(const f32x4*)(LB + cc0), l2 = *(const f32x4*)(LB + cc0 + 16);
                        const f32x4 s1 = {sigmoid_(x1.x), sigmoid_(x1.y), sigmoid_(x1.z), sigmoid_(x1.w)}, s2 = {sigmoid_(x2.x), sigmoid_(x2.y), sigmoid_(x2.z), sigmoid_(x2.w)};
                        const f32x4 f1 = l1 + (1.f - l1) * s1, f2 = l2 + (1.f - l2) * s2;
                        *(f32x4*)LF = (f32x4){__logf(f1.x), __logf(f1.y), __logf(f1.z), __logf(f1.w)}; *(f32x4*)(LF + 16) = (f32x4){__logf(f2.x), __logf(f2.y), __logf(f2.z), __logf(f2.w)};
                    } else if (blk == 3 || blk == 7) { const int t = r & (SEQ - 1); rope_pair(x1, x2, (float)((wc >> 1) ? (t & 63) : (t >> 6)), inv);
                        if (blk == 3) { ::bf16* d = (::bf16*)(ws + WS_KR) + (size_t)r * 512 + lc0; *(u32x2*)d = pk4(x1 * HEAD_SCALE); *(u32x2*)(d + 32) = pk4(x2 * HEAD_SCALE); }
                        else { ::bf16* d = (::bf16*)(ws + WS_QS) + (size_t)r * 1024 + 512 + lc0; *(u32x2*)d = pk4(x1); *(u32x2*)(d + 32) = pk4(x2); }
                    } else { ::bf16* d;
                        if (blk == 2) d = (::bf16*)(ws + WS_VS) + (size_t)r * 1024 + cc0; else if (blk == 4) d = (::bf16*)(ws + WS_VS) + (size_t)r * 1024 + 512 + cc0;
                        else if (blk == 5) { d = (::bf16*)(ws + WS_QS) + (size_t)r * 1024 + cc0; x1 = silu4(x1) * HEAD_SCALE; x2 = silu4(x2) * HEAD_SCALE; }
                        else if (blk == 6) d = (::bf16*)(ws + WS_G) + (size_t)r * 1024 + cc0; else d = (::bf16*)(ws + WS_G) + (size_t)r * 1024 + 512 + cc0;
                        *(u32x2*)d = pk4(x1); *(u32x2*)(d + 16) = pk4(x2); } } }
    }
};
struct EpiResidP {
    static constexpr bool PERM = true, AFTER_DRAIN = false; ::bf16* XA; const float* gate; ::bf16* Hn; const float* ng; const float* sc; float* RSS;
    DEVI void operator()(const f32x4 (&acc)[2][2][4][2], const Unit& u, int wr, int wc, int fr, int fq) const {
        const int bi = (u.pm * BM) >> 13; const float* g = gate + (size_t)bi * 6144; const float* s2 = sc + (size_t)bi * 6144;
        float ss[2][4];
#pragma unroll
        for (int ai = 0; ai < 2; ++ai)
#pragma unroll
            for (int m = 0; m < 4; ++m) ss[ai][m] = 0.f;
#pragma unroll
        for (int bj = 0; bj < 2; ++bj) { const int c = u.pn * BM + 128 * bj + 32 * wc + 8 * fq; const f32x4 g0 = *(const f32x4*)(g + c), g1 = *(const f32x4*)(g + c + 4);

            const f32x4 m0 = *(const f32x4*)(ng + c) * (*(const f32x4*)(s2 + c) + 1.f), m1 = *(const f32x4*)(ng + c + 4) * (*(const f32x4*)(s2 + c + 4) + 1.f);
#pragma unroll
            for (int ai = 0; ai < 2; ++ai) {
                u32x4 xo[4];
#pragma unroll
                for (int m = 0; m < 4; ++m) xo[m] = *(const u32x4*)(XA + (size_t)(u.pm * BM + 128 * ai + 64 * wr + 16 * m + fr) * 1024 + c);
#pragma unroll
                for (int m = 0; m < 4; ++m) { const size_t o = (size_t)(u.pm * BM + 128 * ai + 64 * wr + 16 * m + fr) * 1024 + c; const u32x4 xv = xo[m];
                    const f32x4 x0 = (f32x4){bflo(xv.x), bfhi(xv.x), bflo(xv.y), bfhi(xv.y)} + g0 * acc[ai][bj][m][0], x1 = (f32x4){bflo(xv.z), bfhi(xv.z), bflo(xv.w), bfhi(xv.w)} + g1 * acc[ai][bj][m][1];
                    { const u32x2 xl = pk4(x0), xh = pk4(x1); *(u32x4*)(XA + o) = (u32x4){xl.x, xl.y, xh.x, xh.y}; }
                    const u32x2 lo = pk4(x0 * m0), hi = pk4(x1 * m1); *(u32x4*)(Hn + o) = (u32x4){lo.x, lo.y, hi.x, hi.y};
                    ss[ai][m] += (x0.x * x0.x + x0.y * x0.y + x0.z * x0.z + x0.w * x0.w) + (x1.x * x1.x + x1.y * x1.y + x1.z * x1.z + x1.w * x1.w); } } }
#pragma unroll
        for (int ai = 0; ai < 2; ++ai)
#pragma unroll
            for (int m = 0; m < 4; ++m) { float v = ss[ai][m]; v += swz_xor<16>(v); v = x32_sum(v); if (fq == 0) RSS[(size_t)(u.pm * BM + 128 * ai + 64 * wr + 16 * m + fr) * 16 + u.pn * 4 + wc] = v; }
    }
};
struct EpiBf16P {
    static constexpr bool PERM = true, AFTER_DRAIN = false; ::bf16* O; int ld; const float* RSS; const float* shq;
    DEVI void operator()(const f32x4 (&acc)[2][2][4][2], const Unit& u, int wr, int wc, int fr, int fq) const {
        const float* sq = shq + (size_t)((u.pm * BM) >> 13) * 2048;
        float rs[2][4];
#pragma unroll
        for (int ai = 0; ai < 2; ++ai)
#pragma unroll
            for (int m = 0; m < 4; ++m) rs[ai][m] = rss_rstd(RSS + (size_t)(u.pm * BM + 128 * ai + 64 * wr + 16 * m + fr) * 16);
#pragma unroll
        for (int bj = 0; bj < 2; ++bj) { const int c = u.pn * BM + 128 * bj + 32 * wc + 8 * fq; const f32x4 q0 = *(const f32x4*)(sq + c), q1 = *(const f32x4*)(sq + c + 4);
#pragma unroll
            for (int ai = 0; ai < 2; ++ai)
#pragma unroll
                for (int m = 0; m < 4; ++m) { const u32x2 lo = pk4(acc[ai][bj][m][0] * rs[ai][m] + q0), hi = pk4(acc[ai][bj][m][1] * rs[ai][m] + q1);
                    *(u32x4*)(O + (size_t)(u.pm * BM + 128 * ai + 64 * wr + 16 * m + fr) * ld + c) = (u32x4){lo.x, lo.y, hi.x, hi.y}; } }
    }
};
template <class Epi> DEVI void run(const ::bf16* A, const ::bf16* Bt, int N, unsigned char* lds, const Epi& E) {
    Gemm g{A, Bt, TX, N, 1024}; StaticOrder S; S.init(TX, N, (int)gridDim.x, (int)blockIdx.x);
    gemm_phase<Epi, StaticOrder, true, true>((PG8_LAS unsigned char*)lds, g, S, E);
}
}
#define OPT_GEMM 1

DEVI bool phase_nonempty(int ph) {
    if (ph == 0) return true;
    if (ph == NPHASES - 1) return false;
    const int L = (ph - 1) / NPH_LAYER, s = (ph - 1) % NPH_LAYER;
    if ((L & 1) == 0 && (s == 4 || s == 5 || s == 6)) return false;
    if (OPT_GEMM && (s == 2 || s == 8 || s == 10)) return false;
    if (s == 0 && L > 0) return false;
    return true;
}
DEVI void run_phase(const Params& p, int ph, float* smem) {
    if (ph == 0) { ph_prologue(p, smem); if (OPT_GEMM) { __syncthreads(); ph_weights(p, smem); ph_subkeys(p); ph_gmlp_weights(p); } return; }
    if (ph == NPHASES - 1) return;
    const int L = (ph - 1) / NPH_LAYER, s = (ph - 1) % NPH_LAYER, jl = L >> 1; const bool even = (L & 1) == 0;
    const bf16* H = (const bf16*)(p.ws + WS_H); const float* MOD = (const float*)(p.ws + WS_MOD);
    unsigned char* lds = (unsigned char*)smem;
    { const bool big = gridDim.x >= 256, split = !even && big, late = big && L != DEPTH - 1;
      if (s == (split ? 4 : 9) && !(even && late)) ph_tables(p, L, split ? 128 : 0, split ? (int)gridDim.x - 128 : (int)gridDim.x, !split, 0, late ? TAB_SEL : 16384); }
    switch (s) {
    case 0: if (L == 0) { ph_norm(p, L, 0); ph_shq(p, smem); } break;
    case 1:
            if (even) { const bf16* W = (const bf16*)(p.ws + WT_INE) + (size_t)jl * 2560 * 1024; pg8::EpiEvenP e8{p.ws}; pg8::run(H, W, 2560, lds, e8); EpiEven e{p.ws}; gemm_mfma(H, W, 2560, lds, e, true); }
            else { const bf16* W = (const bf16*)(p.ws + WT_INO) + (size_t)jl * 4608 * 1024; const float* LBl = (const float*)(p.ws + WS_LB) + L * 512; pg8::EpiOddP e8{p.ws, LBl}; pg8::run(H, W, 4608, lds, e8); EpiOdd e{p.ws, LBl}; gemm_mfma(H, W, 4608, lds, e, true); }
            break;
    case 2: break;
    case 3: if (even) { ph_gmlp(p, L, lds); __syncthreads(); ph_attn(p, L, lds);
                        if (gridDim.x >= 256 && L != DEPTH - 1 && (int)blockIdx.x >= 32) ph_tables(p, L, 32, (int)gridDim.x - 32, true, 0, TAB_SEL); }
            else ph_scan1(p, L, lds); break;
    case 4: if (!even) ph_scan2(p); break;
    case 5: if (!even) ph_scan3(p, L, lds); break;
    case 6: if (!even) ph_scan4_naive(p, L); break;
    case 7:
            { const bf16* W = (const bf16*)(p.ws + WT_OUT) + (size_t)L * 1024 * 1024; const float* gt = MOD + (size_t)L * 3 * 6144 + 2048; const float* ng = p.norm_g + (L * 2 + 1) * 1024; const float* sc2 = MOD + (size_t)L * 3 * 6144 + 4096;
              bf16* Hn = (bf16*)(p.ws + WS_H); float* RSS = (float*)(p.ws + WS_RSS) + (size_t)L * T * 16;
              pg8::EpiResidP e8{(bf16*)(p.ws + WS_XA), gt, Hn, ng, sc2, RSS}; pg8::run((const bf16*)(p.ws + WS_OX), W, 1024, lds, e8);
              if (L != DEPTH - 1) { EpiResid e{(bf16*)(p.ws + WS_XA), gt, Hn, ng, sc2, RSS}; gemm_ctx((const bf16*)(p.ws + WS_OX), W, 1024, lds, e); } }
            break;
    case 8: break;
    case 9:
            {
              const bf16* W = (const bf16*)(p.ws + WT_Q) + (size_t)L * 2048 * 1024; const float* RSS = (const float*)(p.ws + WS_RSS) + (size_t)L * T * 16; const float* shq = (const float*)(p.ws + WS_SHQ) + (size_t)L * 3 * 2048;
              pg8::EpiBf16P e8{(bf16*)(p.ws + WS_QP), 2048, RSS, shq}; pg8::run(H, W, 2048, lds, e8); if (L != DEPTH - 1) { EpiBf16Out e{(bf16*)(p.ws + WS_QP), 2048, RSS, shq}; gemm_ctx(H, W, 2048, lds, e); } }
            break;
    case 10: break;
    case 11: ph_peer_select(p, L, smem); if (gridDim.x >= 256 && L != DEPTH - 1 && (int)blockIdx.x >= 32) ph_tables(p, L, 32, (int)gridDim.x - 32, true, TAB_SEL, 16384); break;
    case 12:
#if defined(PROF_GATHER)
            ph_peer_gather<true>(p, L, smem); __syncthreads();
#endif
#if defined(PROF_GDRY)
            ph_gather_dry(p, L); __syncthreads();
#endif
            ph_peer_gather<false>(p, L, smem); break;
    }
}

constexpr int LDS_BYTES = 64 + 132 * 1024;
__global__ void __launch_bounds__(NTHR) mega(Params p) {
    extern __shared__ __attribute__((aligned(16))) unsigned char lds_raw[];
    float* smem = (float*)(lds_raw + 64);
    volatile unsigned* st = (volatile unsigned*)lds_raw;
#if MK_SINGLE
    if (threadIdx.x < 16) st[threadIdx.x] = 0u;
    __syncthreads();
    XcdBarrier bar = xcd_barrier_post((unsigned*)(p.ws + WS_CTL) + 4096, st);
#endif
    for (int ph = p.ph_lo; ph < p.ph_hi; ++ph) {
        if (!phase_nonempty(ph)) continue;
        Params q = p;
        { const float** qq = (const float**)&q;
#pragma unroll
          for (int i = 0; i < 24; ++i) { const float __attribute__((address_space(1)))* gpt = (const float __attribute__((address_space(1)))*)qq[i]; asm volatile("" : "+s"(gpt)); qq[i] = (const float*)gpt; }
          { unsigned char __attribute__((address_space(1)))* gw = (unsigned char __attribute__((address_space(1)))*)q.ws; asm volatile("" : "+s"(gw)); q.ws = (unsigned char*)gw; }
          { float __attribute__((address_space(1)))* go = (float __attribute__((address_space(1)))*)q.out; asm volatile("" : "+s"(go)); q.out = (float*)go; } }
        {
            int nrep = 1;
#if defined(PROF_STEP)
            if (ph > 0 && ph < NPHASES - 1 && (ph - 1) % NPH_LAYER == PROF_STEP && (((ph - 1) / NPH_LAYER) & 1) == PROF_PAR) nrep += (p.ph_lo == 0) ? PROF_NREP : 0;
#endif
            for (int rep = 0; rep < nrep; ++rep) { if (rep) __syncthreads(); run_phase(q, ph, smem); }
        }
#if MK_SINGLE
        if (ph + 1 < p.ph_hi) xcd_barrier(bar);
#endif
    }
}

extern "C" void kernel_launch(void* const* d_in, const int* in_sizes, int n_in, void* d_out, int out_size, void* d_ws, size_t ws_size, hipStream_t stream) {
    static int grid = 0;
    if (grid == 0) {
        if (n_in != 24 || out_size != TX * D || ws_size < WS_END) { fprintf(stderr, "kernel_launch: unexpected shapes (n_in %d out %d ws %zu)\n", n_in, out_size, ws_size); grid = -1; return; }
        int dev = 0, cus = 0, per_cu = 0;
        (void)hipGetDevice(&dev); (void)hipDeviceGetAttribute(&cus, hipDeviceAttributeMultiprocessorCount, dev);
        (void)hipFuncSetAttribute((const void*)mega, hipFuncAttributeMaxDynamicSharedMemorySize, LDS_BYTES);
        if (hipOccupancyMaxActiveBlocksPerMultiprocessor(&per_cu, (const void*)mega, NTHR, LDS_BYTES) != hipSuccess || per_cu < 1) per_cu = 1;
        if (per_cu > 1) per_cu = 1;
        grid = cus * per_cu;
        fprintf(stderr, "kernel_launch: grid %d (%d CUs x %d)\n", grid, cus, per_cu);
    }
    if (grid < 0) return;
    Params p{};
    const float** pp = (const float**)&p;
    for (int i = 0; i < 24; ++i) pp[i] = (const float*)d_in[i];
    p.out = (float*)d_out; p.ws = (unsigned char*)d_ws;
#if MK_SINGLE
    (void)hipMemsetAsync((char*)d_ws + WS_CTL, 0, 1 * MiB, stream);
    p.ph_lo = 0; p.ph_hi = NPHASES;
    void* args[] = {&p};
    hipError_t e = hipLaunchCooperativeKernel((const void*)mega, dim3(grid), dim3(NTHR), args, LDS_BYTES, stream);
    if (e != hipSuccess) fprintf(stderr, "cooperative launch failed: %s (grid %d)\n", hipGetErrorString(e), grid);
#else
    for (int ph = 0; ph < NPHASES; ++ph) {
        bool ne = true;
        if (ph != 0 && ph != NPHASES - 1) { const int L = (ph - 1) / NPH_LAYER, s = (ph - 1) % NPH_LAYER; if ((L & 1) == 0 && (s == 4 || s == 5 || s == 6)) ne = false; }
        if (!ne) continue;
        p.ph_lo = ph; p.ph_hi = ph + 1;
        hipLaunchKernelGGL(mega, dim3(grid), dim3(NTHR), LDS_BYTES, stream, p);
    }
#endif
}
```
